# Optimizing an MI355X kernel written in HIP

```python
import math
import jax, jax.numpy as jnp
from jax import lax
import numpy as np

D_MODEL = 1024
BATCH = 2
SEQ = 8192
DEPTH = 2

N_EVEN = (DEPTH + 1) // 2
N_ODD = DEPTH // 2
NORM_EPS = 1e-6
Q_BLOCK = 128
D_FF = 2816
S5_WIDTH = D_MODEL // 2
S5_GROUP_CH = 16
S5_GROUPS = S5_WIDTH // S5_GROUP_CH
S5_STATE = 64
S5_DT_MIN = 1e-3
S5_DT_MAX = 1e-1
MLA_HEADS = 8
MLA_NOPE = 64
MLA_ROPE = 32
MLA_V = 64
MLA_Q_LORA = 384
MLA_KV_LORA = 256
MLA_ROPE_THETA = 10000.0
EVEN_IN = S5_WIDTH + MLA_Q_LORA + MLA_KV_LORA + MLA_ROPE
EVEN_MIX = S5_WIDTH + MLA_HEADS * MLA_V
DIFF_HEADS = 8
DIFF_HEAD_DIM = D_MODEL // DIFF_HEADS // 2
DIFF_ROT = DIFF_HEAD_DIM // 4
ROPE_THETA = 500000.0
ODD_IN = 3 * DIFF_HEADS * 2 * DIFF_HEAD_DIM
ODD_MIX = DIFF_HEADS * 2 * DIFF_HEAD_DIM

kernel_name = "hybrid_s5_mla_diffattn_macaron"

F32 = jnp.float32


def _rmsnorm(x, g):
    xf = x.astype(F32)
    y = xf * lax.rsqrt(jnp.mean(xf * xf, axis=-1, keepdims=True) + NORM_EPS)
    return (y * g.astype(F32)).astype(x.dtype)


def _swiglu(h, w_gu, w_down):
    g, u = jnp.split(h @ w_gu, 2, axis=-1)
    return (jax.nn.silu(g) * u) @ w_down


def _rope_tables(positions, rot_dim, theta):
    half = rot_dim // 2
    inv = theta ** (-jnp.arange(half, dtype=F32) * 2.0 / rot_dim)
    ang = positions.astype(F32)[..., None] * inv
    return jnp.cos(ang), jnp.sin(ang)


def _apply_rope(x, cos, sin):
    half = cos.shape[-1]
    shape = (cos.shape[0],) + (1,) * (x.ndim - 3) + cos.shape[1:]
    c = cos.reshape(shape)
    s = sin.reshape(shape)
    xf = x.astype(F32)
    x1 = xf[..., :half]
    x2 = xf[..., half:2 * half]
    out = jnp.concatenate([x1 * c - x2 * s, x2 * c + x1 * s, xf[..., 2 * half:]], axis=-1)
    return out.astype(x.dtype)


def _causal_mask(i, s):
    qpos = i * Q_BLOCK + jnp.arange(Q_BLOCK)
    return jnp.arange(s)[None, :] <= qpos[:, None]


def _causal_attention(q, k, v):
    bsz, nh, s, dk = q.shape
    dv = v.shape[-1]
    nb = s // Q_BLOCK
    scale = dk ** -0.5
    qb = q.reshape(bsz, nh, nb, Q_BLOCK, dk).transpose(2, 0, 1, 3, 4)

    def block(args):
        qi, i = args
        sc = jnp.einsum('bhqd,bhkd->bhqk', qi, k).astype(F32) * scale
        sc = jnp.where(_causal_mask(i, s), sc, -jnp.inf)
        p = jax.nn.softmax(sc, axis=-1)
        return jnp.einsum('bhqk,bhkd->bhqd', p.astype(v.dtype), v)

    o = lax.map(block, (qb, jnp.arange(nb)))
    return o.transpose(1, 2, 0, 3, 4).reshape(bsz, nh, s, dv)


def _diff_attention(q, k, v, lam):
    bsz, nh, _, s, d = q.shape
    dv = v.shape[-1]
    nb = s // Q_BLOCK
    scale = d ** -0.5
    qb = q.reshape(bsz, nh, 2, nb, Q_BLOCK, d).transpose(3, 0, 1, 2, 4, 5)

    def block(args):
        qi, i = args
        sc = jnp.einsum('bhmqd,bhmkd->bhmqk', qi, k).astype(F32) * scale
        sc = jnp.where(_causal_mask(i, s), sc, -jnp.inf)
        p = jax.nn.softmax(sc, axis=-1)
        w = p[:, :, 0] - lam * p[:, :, 1]
        return jnp.einsum('bhqk,bhkd->bhqd', w.astype(v.dtype), v)

    o = lax.map(block, (qb, jnp.arange(nb)))
    return o.transpose(1, 2, 0, 3, 4).reshape(bsz, nh, s, dv)


def _s5(u, lam_re, lam_im, log_dt, b_re, b_im, c_re, c_im, d_skip, w_glu, b_glu):
    bsz, s, _ = u.shape
    uf = u.astype(F32).reshape(bsz, s, S5_GROUPS, S5_GROUP_CH)
    dt = jnp.exp(log_dt.astype(F32))[:, None]
    lr = lam_re.astype(F32)
    li = lam_im.astype(F32)
    mag = jnp.exp(lr * dt)
    ang = li * dt
    ab_re = mag * jnp.cos(ang)
    ab_im = mag * jnp.sin(ang)
    den = lr * lr + li * li
    nr = ab_re - 1.0
    f_re = (nr * lr + ab_im * li) / den
    f_im = (ab_im * lr - nr * li) / den
    br = b_re.astype(F32)
    bi = b_im.astype(F32)
    bb_re = f_re[..., None] * br - f_im[..., None] * bi
    bb_im = f_re[..., None] * bi + f_im[..., None] * br
    bu_re = jnp.einsum('bsgh,gph->sbgp', uf, bb_re)
    bu_im = jnp.einsum('bsgh,gph->sbgp', uf, bb_im)
    a_re = jnp.broadcast_to(ab_re[None, None], (s, 1, S5_GROUPS, S5_STATE))
    a_im = jnp.broadcast_to(ab_im[None, None], (s, 1, S5_GROUPS, S5_STATE))

    def combine(e_i, e_j):
        ar_i, ai_i, xr_i, xi_i = e_i
        ar_j, ai_j, xr_j, xi_j = e_j
        return (ar_j * ar_i - ai_j * ai_i,
                ar_j * ai_i + ai_j * ar_i,
                ar_j * xr_i - ai_j * xi_i + xr_j,
                ar_j * xi_i + ai_j * xr_i + xi_j)

    _, _, x_re, x_im = lax.associative_scan(combine, (a_re, a_im, bu_re, bu_im), axis=0)
    y = (jnp.einsum('sbgp,ghp->bsgh', x_re, c_re.astype(F32))
         - jnp.einsum('sbgp,ghp->bsgh', x_im, c_im.astype(F32))
         + d_skip.astype(F32) * uf)
    g = jax.nn.gelu(y.reshape(bsz, s, S5_WIDTH))
    out = g * jax.nn.sigmoid(g @ w_glu.astype(F32) + b_glu.astype(F32))
    return out.astype(u.dtype)


def _even_mixer(h, cos_m, sin_m, w_in, lam_re, lam_im, log_dt, b_re, b_im, c_re, c_im,
                d_skip, w_glu, b_glu, q_norm, w_uq, kv_norm, w_ukv, w_out):
    bsz, s, _ = h.shape
    proj = h @ w_in
    u, c_q, c_kv, k_rope = jnp.split(
        proj, [S5_WIDTH, S5_WIDTH + MLA_Q_LORA, S5_WIDTH + MLA_Q_LORA + MLA_KV_LORA], axis=-1)
    s5_out = _s5(u, lam_re, lam_im, log_dt, b_re, b_im, c_re, c_im, d_skip, w_glu, b_glu)
    q = (_rmsnorm(c_q, q_norm) @ w_uq).reshape(bsz, s, MLA_HEADS, MLA_NOPE + MLA_ROPE).transpose(0, 2, 1, 3)
    kv = (_rmsnorm(c_kv, kv_norm) @ w_ukv).reshape(bsz, s, MLA_HEADS, MLA_NOPE + MLA_V).transpose(0, 2, 1, 3)
    k_nope, v = kv[..., :MLA_NOPE], kv[..., MLA_NOPE:]
    q_pe = _apply_rope(q[..., MLA_NOPE:], cos_m, sin_m)
    k_pe = _apply_rope(k_rope, cos_m, sin_m)[:, None]
    q_full = jnp.concatenate([q[..., :MLA_NOPE], q_pe], axis=-1)
    k_full = jnp.concatenate([k_nope, jnp.broadcast_to(k_pe, (bsz, MLA_HEADS, s, MLA_ROPE))], axis=-1)
    o = _causal_attention(q_full, k_full, v)
    o = o.transpose(0, 2, 1, 3).reshape(bsz, s, MLA_HEADS * MLA_V)
    return jnp.concatenate([s5_out, o], axis=-1) @ w_out


def _odd_mixer(h, cos_t, sin_t, layer_idx, w_in, lq1, lk1, lq2, lk2, subln, w_out):
    bsz, s, _ = h.shape
    q, k, v = jnp.split(h @ w_in, 3, axis=-1)
    q = q.reshape(bsz, s, DIFF_HEADS, 2, DIFF_HEAD_DIM).transpose(0, 2, 3, 1, 4)
    k = k.reshape(bsz, s, DIFF_HEADS, 2, DIFF_HEAD_DIM).transpose(0, 2, 3, 1, 4)
    v = v.reshape(bsz, s, DIFF_HEADS, 2 * DIFF_HEAD_DIM).transpose(0, 2, 1, 3)
    q = _apply_rope(q, cos_t, sin_t)
    k = _apply_rope(k, cos_t, sin_t)
    lam_init = 0.8 - 0.6 * math.exp(-0.3 * layer_idx)
    lam = (jnp.exp(jnp.sum(lq1.astype(F32) * lk1.astype(F32)))
           - jnp.exp(jnp.sum(lq2.astype(F32) * lk2.astype(F32))) + lam_init)
    o = _diff_attention(q, k, v, lam)
    o = _rmsnorm(o, subln) * (1.0 - lam_init)
    o = o.transpose(0, 2, 1, 3).reshape(bsz, s, ODD_MIX)
    return o @ w_out


def setup_inputs(seed: int = 0) -> dict:
    key = jax.random.key(seed)
    ks = iter(jax.random.split(key, 32))

    def nrm(shape, scale):
        return jax.random.normal(next(ks), shape, F32) * scale

    def gain(shape):
        return 1.0 + nrm(shape, 0.02)

    G, P, H = S5_GROUPS, S5_STATE, S5_GROUP_CH
    x = nrm((BATCH, SEQ, D_MODEL), 1.0)
    positions = jnp.broadcast_to(jnp.arange(SEQ, dtype=jnp.int32)[None, :], (BATCH, SEQ))
    ffn_norm = gain((DEPTH, 2, D_MODEL))
    ffn_w_gu = nrm((DEPTH, 2, D_MODEL, 2 * D_FF), D_MODEL ** -0.5)
    ffn_w_down = nrm((DEPTH, 2, D_FF, D_MODEL), D_FF ** -0.5)
    ev_norm = gain((N_EVEN, D_MODEL))
    ev_w_in = nrm((N_EVEN, D_MODEL, EVEN_IN), D_MODEL ** -0.5)
    s5_lambda_re = -0.5 + nrm((N_EVEN, G, P), 0.01)
    s5_lambda_im = jnp.pi * jnp.arange(P, dtype=F32)[None, None, :] + nrm((N_EVEN, G, P), 0.01)
    s5_log_dt = jax.random.uniform(next(ks), (N_EVEN, G), F32,
                                   minval=math.log(S5_DT_MIN), maxval=math.log(S5_DT_MAX))
    s5_b_re = nrm((N_EVEN, G, P, H), (2 * H) ** -0.5)
    s5_b_im = nrm((N_EVEN, G, P, H), (2 * H) ** -0.5)
    s5_c_re = nrm((N_EVEN, G, H, P), P ** -0.5)
    s5_c_im = nrm((N_EVEN, G, H, P), P ** -0.5)
    s5_d = nrm((N_EVEN, G, H), 1.0)
    s5_w_glu = nrm((N_EVEN, S5_WIDTH, S5_WIDTH), S5_WIDTH ** -0.5)
    s5_b_glu = nrm((N_EVEN, S5_WIDTH), 0.01)
    mla_q_norm = gain((N_EVEN, MLA_Q_LORA))
    mla_w_uq = nrm((N_EVEN, MLA_Q_LORA, MLA_HEADS * (MLA_NOPE + MLA_ROPE)), MLA_Q_LORA ** -0.5)
    mla_kv_norm = gain((N_EVEN, MLA_KV_LORA))
    mla_w_ukv = nrm((N_EVEN, MLA_KV_LORA, MLA_HEADS * (MLA_NOPE + MLA_V)), MLA_KV_LORA ** -0.5)
    ev_w_out = nrm((N_EVEN, EVEN_MIX, D_MODEL), EVEN_MIX ** -0.5)
    od_norm = gain((N_ODD, D_MODEL))
    od_w_in = nrm((N_ODD, D_MODEL, ODD_IN), D_MODEL ** -0.5)
    diff_lq1 = nrm((N_ODD, DIFF_HEAD_DIM), 0.1)
    diff_lk1 = nrm((N_ODD, DIFF_HEAD_DIM), 0.1)
    diff_lq2 = nrm((N_ODD, DIFF_HEAD_DIM), 0.1)
    diff_lk2 = nrm((N_ODD, DIFF_HEAD_DIM), 0.1)
    diff_subln = gain((N_ODD, 2 * DIFF_HEAD_DIM))
    od_w_out = nrm((N_ODD, ODD_MIX, D_MODEL), ODD_MIX ** -0.5)
    final_norm = gain((D_MODEL,))
    return {"x": x, "positions": positions, "ffn_norm": ffn_norm, "ffn_w_gu": ffn_w_gu,
            "ffn_w_down": ffn_w_down, "ev_norm": ev_norm, "ev_w_in": ev_w_in,
            "s5_lambda_re": s5_lambda_re, "s5_lambda_im": s5_lambda_im, "s5_log_dt": s5_log_dt,
            "s5_b_re": s5_b_re, "s5_b_im": s5_b_im, "s5_c_re": s5_c_re, "s5_c_im": s5_c_im,
            "s5_d": s5_d, "s5_w_glu": s5_w_glu, "s5_b_glu": s5_b_glu, "mla_q_norm": mla_q_norm,
            "mla_w_uq": mla_w_uq, "mla_kv_norm": mla_kv_norm, "mla_w_ukv": mla_w_ukv,
            "ev_w_out": ev_w_out, "od_norm": od_norm, "od_w_in": od_w_in, "diff_lq1": diff_lq1,
            "diff_lk1": diff_lk1, "diff_lq2": diff_lq2, "diff_lk2": diff_lk2,
            "diff_subln": diff_subln, "od_w_out": od_w_out, "final_norm": final_norm}


def reference(x, positions, ffn_norm, ffn_w_gu, ffn_w_down, ev_norm, ev_w_in, s5_lambda_re,
              s5_lambda_im, s5_log_dt, s5_b_re, s5_b_im, s5_c_re, s5_c_im, s5_d, s5_w_glu,
              s5_b_glu, mla_q_norm, mla_w_uq, mla_kv_norm, mla_w_ukv, ev_w_out, od_norm, od_w_in,
              diff_lq1, diff_lk1, diff_lq2, diff_lk2, diff_subln, od_w_out, final_norm):
    cos_t, sin_t = _rope_tables(positions, DIFF_ROT, ROPE_THETA)
    cos_m, sin_m = _rope_tables(positions, MLA_ROPE, MLA_ROPE_THETA)
    for l in range(DEPTH):
        x = x + 0.5 * _swiglu(_rmsnorm(x, ffn_norm[l, 0]), ffn_w_gu[l, 0], ffn_w_down[l, 0])
        i = l // 2
        if l % 2 == 0:
            h = _rmsnorm(x, ev_norm[i])
            x = x + _even_mixer(h, cos_m, sin_m, ev_w_in[i], s5_lambda_re[i], s5_lambda_im[i],
                                s5_log_dt[i], s5_b_re[i], s5_b_im[i], s5_c_re[i], s5_c_im[i],
                                s5_d[i], s5_w_glu[i], s5_b_glu[i], mla_q_norm[i], mla_w_uq[i],
                                mla_kv_norm[i], mla_w_ukv[i], ev_w_out[i])
        else:
            h = _rmsnorm(x, od_norm[i])
            x = x + _odd_mixer(h, cos_t, sin_t, l, od_w_in[i], diff_lq1[i], diff_lk1[i],
                               diff_lq2[i], diff_lk2[i], diff_subln[i], od_w_out[i])
        x = x + 0.5 * _swiglu(_rmsnorm(x, ffn_norm[l, 1]), ffn_w_gu[l, 1], ffn_w_down[l, 1])
    return _rmsnorm(x, final_norm)
```

```cpp
#include <hip/hip_runtime.h>
#include <hip/hip_cooperative_groups.h>
#include <cstdio>
#include <cstdint>
namespace cg = cooperative_groups;
__device__ __forceinline__ int opaque_tid() { int t = threadIdx.x; asm volatile("" : "+v"(t)); return t; }
namespace pg8 {
#define PG8_LAS __attribute__((address_space(3)))
typedef unsigned short bf16_t;
typedef short bf16x8 __attribute__((ext_vector_type(8)));
typedef float f32x4 __attribute__((ext_vector_type(4)));
typedef unsigned u32x4 __attribute__((ext_vector_type(4)));
constexpr int BM = 256, BK = 64, HALF = 128, HTB = HALF * BK * 2  , STAGE_BYTES = 8 * HTB, NXCD = 8, WGM = 8;

__host__ __device__ __forceinline__ int lds_byte(int r, int c) { const int st = (r >> 4) * 2 + (c >> 5), rr = r & 15, cc = c & 31, ob = rr * 64 + cc * 2; return st * 1024 + (ob ^ (((ob >> 9) & 1) << 5)); }
__host__ __device__ __forceinline__ void stage_rc(int b, int& R, int& C) { const int st = b / 1024, sb = b % 1024, swz = sb ^ (((sb >> 9) & 1) << 5); R = (st >> 1) * 16 + swz / 64; C = (st & 1) * 32 + (swz % 64) / 2; }
__host__ __device__ __forceinline__ int perm32(int rho) { const int n = rho >> 4, i = rho & 15; return 8 * (i >> 2) + 4 * n + (i & 3); }

struct Unit { int pm, pn; };
struct Gemm { const bf16_t* A; const bf16_t* Bt; int M, N, K, lda, ldb; };

struct StaticOrder {
    int nM, nN, nwg, G, c;
    __host__ __device__ void init(int M, int N, int G_, int c_) { nM = M / BM; nN = N / BM; nwg = nM * nN; G = G_; c = c_; }
    __host__ __device__ bool next(int i, Unit& u) const {
        const long L = (long)i * G + c; if (L >= nwg) return false;
        int wgid = (int)L; { const int q = nwg / NXCD, r = nwg % NXCD, xcd = wgid % NXCD, off = wgid / NXCD; wgid = (xcd < r ? xcd * (q + 1) : r * (q + 1) + (xcd - r) * q) + off; }
        const int nig = WGM * nN, gid = wgid / nig, fm = gid * WGM, gsz = (nM - fm) < WGM ? (nM - fm) : WGM;
        u.pm = fm + ((wgid % nig) % gsz); u.pn = (wgid % nig) / gsz; return true;
    }
    __device__ __forceinline__ void a_ready(const Unit&) const {}
    __device__ __forceinline__ void done(const Unit&) const {}
};
template <class Epi, class Sched, bool ALIGN_EPI = false, bool SP2 = false>
__device__ __forceinline__ void gemm_phase(PG8_LAS unsigned char* lds, const Gemm g, const Sched& S, const Epi& E) {
    const int tid = opaque_tid(), wid = __builtin_amdgcn_readfirstlane(tid >> 6), lane = tid & 63, wr = wid >> 2, wc = wid & 3, fr = lane & 15, fq = lane >> 4;
    int nt_ = g.K / BK; asm volatile("" : "+s"(nt_)); const int nt = nt_;
    unsigned voffA[2], voffB[2];
#pragma unroll
    for (int i = 0; i < 2; ++i) { int R, C; stage_rc(tid * 16 + i * 8192, R, C); const int Rb = Epi::PERM ? ((R & ~31) + perm32(R & 31)) : R;
        voffA[i] = (unsigned)(R * g.lda + C) * 2u; voffB[i] = (unsigned)(Rb * g.ldb + C) * 2u; }
    const size_t kstep = (size_t)(BK * 2);
    const size_t hstepA = (size_t)HALF * g.lda * 2, hstepB = (size_t)HALF * g.ldb * 2;
    const size_t tstepA = 2 * hstepA, tstepB = 2 * hstepB;
    const unsigned ldsw = (unsigned)wid * 1024u;
    const int aoff = lds_byte(wr * 64 + fr, fq * 8), boff = lds_byte(wc * 32 + fr, fq * 8);
#define PG8_SA(b, h) (((b) * 2 + (h)) * HTB)
#define PG8_SB(b, h) ((4 + (b) * 2 + (h)) * HTB)
#define PG8_STAGE(bufoff, gbase, voff) do { _Pragma("unroll") for (int _i = 0; _i < 2; ++_i) \
        __builtin_amdgcn_global_load_lds((const unsigned*)((const char*)(gbase) + (voff)[_i]), (PG8_LAS unsigned*)(lds + (bufoff) + ldsw + _i * 8192), 16, 0, 0); } while (0)
#define PG8_LDA(dst, b, h) do { _Pragma("unroll") for (int m = 0; m < 4; ++m) _Pragma("unroll") for (int k = 0; k < 2; ++k) dst[m][k] = *(const PG8_LAS bf16x8*)(lds + PG8_SA(b, h) + aoff + m * 2048 + k * 1024); } while (0)
#define PG8_LDB(dst, b, h) do { _Pragma("unroll") for (int n = 0; n < 2; ++n) _Pragma("unroll") for (int k = 0; k < 2; ++k) dst[n][k] = *(const PG8_LAS bf16x8*)(lds + PG8_SB(b, h) + boff + n * 2048 + k * 1024); } while (0)
#define PG8_MMA(ai, bj, At, Bt) do { __builtin_amdgcn_s_setprio(1); _Pragma("unroll") for (int m = 0; m < 4; ++m) _Pragma("unroll") for (int n = 0; n < 2; ++n) _Pragma("unroll") for (int k = 0; k < 2; ++k) \
        acc[ai][bj][m][n] = __builtin_amdgcn_mfma_f32_16x16x32_bf16(Bt[n][k], At[m][k], acc[ai][bj][m][n], 0, 0, 0); __builtin_amdgcn_s_setprio(0); } while (0)
#define PG8_WAIT_V(n) asm volatile("s_waitcnt vmcnt(" #n ")" ::: "memory")
#define PG8_WAIT_L(n) asm volatile("s_waitcnt lgkmcnt(" #n ")" ::: "memory")
#define PG8_BAR __builtin_amdgcn_s_barrier()
#define PG8_SCHED __builtin_amdgcn_sched_barrier(0)
    Unit cur, nxt; int ui = 0;
    if (!S.next(0, cur)) return;
    f32x4 acc[2][2][4][2];
#pragma unroll
    for (int a = 0; a < 2; ++a)
#pragma unroll
        for (int b = 0; b < 2; ++b)
#pragma unroll
            for (int m = 0; m < 4; ++m)
#pragma unroll
                for (int n = 0; n < 2; ++n) acc[a][b][m][n] = (f32x4){0.f, 0.f, 0.f, 0.f};
    bf16x8 At[4][2], B0[2][2], B1[2][2];
    const char* cA = (const char*)g.A + (size_t)cur.pm * tstepA; const char* cB = (const char*)g.Bt + (size_t)cur.pn * tstepB;
    S.a_ready(cur);
    if constexpr (SP2) {
        PG8_STAGE(PG8_SB(0, 0), cB, voffB); PG8_STAGE(PG8_SB(0, 1), cB + hstepB, voffB); PG8_STAGE(PG8_SA(0, 0), cA, voffA); PG8_STAGE(PG8_SA(0, 1), cA + hstepA, voffA);
        if (wr == 1) PG8_BAR;
        PG8_WAIT_V(2); PG8_BAR;
        PG8_STAGE(PG8_SB(1, 0), cB + kstep, voffB); PG8_STAGE(PG8_SA(1, 0), cA + kstep, voffA); PG8_STAGE(PG8_SB(1, 1), cB + hstepB + kstep, voffB);
        PG8_WAIT_V(6); PG8_BAR;
    } else {
        PG8_STAGE(PG8_SB(0, 0), cB, voffB); PG8_STAGE(PG8_SA(0, 0), cA, voffA); PG8_STAGE(PG8_SB(0, 1), cB + hstepB, voffB); PG8_STAGE(PG8_SA(0, 1), cA + hstepA, voffA);
        if (wr == 1) PG8_BAR;
        PG8_WAIT_V(4); PG8_BAR;
        PG8_STAGE(PG8_SB(1, 0), cB + kstep, voffB); PG8_STAGE(PG8_SA(1, 0), cA + kstep, voffA); PG8_STAGE(PG8_SB(1, 1), cB + hstepB + kstep, voffB);
        PG8_WAIT_V(6); PG8_BAR;
    }
    for (;;) {
        const bool has_next = S.next(ui + 1, nxt);
        const char* nA = has_next ? (const char*)g.A + (size_t)nxt.pm * tstepA : cA; const char* nB = has_next ? (const char*)g.Bt + (size_t)nxt.pn * tstepB : cB;
        for (int t = 0; t < nt; t += 2) {
            const bool last = (t == nt - 2);
            const char* a1 = cA + (size_t)(t + 1) * kstep;
            const char* a2 = last ? nA : cA + (size_t)(t + 2) * kstep; const char* b2 = last ? nB : cB + (size_t)(t + 2) * kstep;
            const char* a3 = a2 + kstep; const char* b3 = b2 + kstep;
            if (last && has_next) S.a_ready(nxt);
            if constexpr (SP2) {
            PG8_LDB(B0, 0, 0); PG8_LDB(B1, 0, 1); PG8_SCHED; PG8_LDA(At, 0, 0); PG8_STAGE(PG8_SA(1, 1), a1 + hstepA, voffA);
            PG8_WAIT_V(8); PG8_WAIT_L(0); PG8_BAR; PG8_MMA(0, 0, At, B0); PG8_MMA(0, 1, At, B1); PG8_BAR; PG8_SCHED;
            PG8_LDA(At, 0, 1); PG8_STAGE(PG8_SB(0, 0), b2, voffB); PG8_STAGE(PG8_SB(0, 1), b2 + hstepB, voffB); PG8_STAGE(PG8_SA(0, 0), a2, voffA);
            PG8_WAIT_V(8); PG8_WAIT_L(0); PG8_BAR; PG8_MMA(1, 0, At, B0); PG8_MMA(1, 1, At, B1); PG8_BAR; PG8_SCHED;
            PG8_LDB(B0, 1, 0); PG8_LDB(B1, 1, 1); PG8_SCHED; PG8_LDA(At, 1, 0); PG8_STAGE(PG8_SA(0, 1), a2 + hstepA, voffA);
            PG8_WAIT_V(8); PG8_WAIT_L(0); PG8_BAR; PG8_MMA(0, 0, At, B0); PG8_MMA(0, 1, At, B1); PG8_BAR; PG8_SCHED;
            PG8_LDA(At, 1, 1); PG8_STAGE(PG8_SB(1, 0), b3, voffB); PG8_STAGE(PG8_SB(1, 1), b3 + hstepB, voffB); PG8_STAGE(PG8_SA(1, 0), a3, voffA);
            PG8_WAIT_V(8); PG8_WAIT_L(0); PG8_BAR; PG8_MMA(1, 0, At, B0); PG8_MMA(1, 1, At, B1); PG8_BAR; PG8_SCHED;
            } else {
            PG8_LDB(B0, 0, 0); PG8_SCHED; PG8_LDA(At, 0, 0); PG8_STAGE(PG8_SA(1, 1), a1 + hstepA, voffA);
            PG8_WAIT_L(8); PG8_BAR; PG8_WAIT_L(0); PG8_MMA(0, 0, At, B0); PG8_BAR; PG8_SCHED;
            PG8_LDB(B1, 0, 1); PG8_STAGE(PG8_SB(0, 0), b2, voffB);
            PG8_BAR; PG8_WAIT_L(0); PG8_MMA(0, 1, At, B1); PG8_BAR;
            PG8_LDA(At, 0, 1); PG8_STAGE(PG8_SA(0, 0), a2, voffA);
            PG8_BAR; PG8_WAIT_L(0); PG8_MMA(1, 0, At, B0); PG8_BAR; PG8_SCHED;
            PG8_STAGE(PG8_SB(0, 1), b2 + hstepB, voffB);
            PG8_WAIT_V(6); PG8_BAR; PG8_MMA(1, 1, At, B1); PG8_BAR;
            PG8_LDB(B0, 1, 0); PG8_SCHED; PG8_LDA(At, 1, 0); PG8_STAGE(PG8_SA(0, 1), a2 + hstepA, voffA);
            PG8_WAIT_L(8); PG8_BAR; PG8_WAIT_L(0); PG8_MMA(0, 0, At, B0); PG8_BAR; PG8_SCHED;
            PG8_LDB(B1, 1, 1); PG8_STAGE(PG8_SB(1, 0), b3, voffB);
            PG8_BAR; PG8_WAIT_L(0); PG8_MMA(0, 1, At, B1); PG8_BAR;
            PG8_LDA(At, 1, 1); PG8_STAGE(PG8_SA(1, 0), a3, voffA);
            PG8_BAR; PG8_WAIT_L(0); PG8_MMA(1, 0, At, B0); PG8_BAR; PG8_SCHED;
            PG8_STAGE(PG8_SB(1, 1), b3 + hstepB, voffB);
            PG8_WAIT_V(6); PG8_BAR; PG8_MMA(1, 1, At, B1); PG8_BAR;
            }
        }
        if constexpr (ALIGN_EPI) { if (wr == 0) PG8_BAR; }
        if constexpr (!Epi::AFTER_DRAIN) { E(acc, cur, wr, wc, fr, fq); S.done(cur); }
        if (!has_next) break;
#pragma unroll
        for (int a = 0; a < 2; ++a)
#pragma unroll
            for (int b = 0; b < 2; ++b)
#pragma unroll
                for (int m = 0; m < 4; ++m)
#pragma unroll
                    for (int n = 0; n < 2; ++n) acc[a][b][m][n] = (f32x4){0.f, 0.f, 0.f, 0.f};
        cur = nxt; cA = nA; cB = nB; ++ui;
        if constexpr (ALIGN_EPI) { if (wr == 1) PG8_BAR; }
    }
    PG8_WAIT_V(0);
    if constexpr (!ALIGN_EPI) { if (wr == 0) PG8_BAR; }
    PG8_BAR;
    if constexpr (Epi::AFTER_DRAIN) { E.fused(acc, cur, wr, wc, fr, fq, lds, wid, lane); S.done(cur); }
#undef PG8_SA
#undef PG8_SB
#undef PG8_STAGE
#undef PG8_LDA
#undef PG8_LDB
#undef PG8_MMA
#undef PG8_WAIT_V
#undef PG8_WAIT_L
#undef PG8_BAR
#undef PG8_SCHED
}
}
#define LAS __attribute__((address_space(3)))
typedef unsigned short bf16_t;
typedef short bf16x8 __attribute__((ext_vector_type(8)));
typedef float f32x4 __attribute__((ext_vector_type(4)));
typedef float f32x2 __attribute__((ext_vector_type(2)));
typedef float f32x16 __attribute__((ext_vector_type(16)));
typedef unsigned u32x4 __attribute__((ext_vector_type(4)));
typedef unsigned u32x2 __attribute__((ext_vector_type(2)));
typedef __bf16 bf16x2_t __attribute__((ext_vector_type(2)));
using pg8::Unit;

constexpr int T_ = 16384, S_ = 8192, D_ = 1024, FF_ = 2816;
constexpr float EPS = 1e-6f, LOG2E = 1.4426950408889634f;
constexpr float QSCALE1 = 0.10206207261596575f * LOG2E;
constexpr float QSCALE2 = 0.125f * LOG2E;
constexpr float LAM_INIT = 0.35550906759096934f;
constexpr size_t MiB = 1u << 20;
constexpr size_t WS_SS = 0, WS_S5P = 1 * MiB, WS_ROPE = 2 * MiB;
constexpr size_t WS_WGU = 6 * MiB, WS_WD = 50 * MiB, WS_WEVIN = 72 * MiB, WS_WUQ = 75 * MiB, WS_WUKV = 76 * MiB, WS_WGLU = 77 * MiB, WS_WEVOUT = 78 * MiB, WS_WODIN = 80 * MiB, WS_WODOUT = 86 * MiB;
constexpr size_t WS_XB = 88 * MiB, WS_OV = 120 * MiB;
constexpr size_t WS_ACT = WS_OV;
constexpr size_t WS_U = WS_OV, WS_CQ = WS_OV + 32 * MiB, WS_CKV = WS_OV + 44 * MiB, WS_KPE = WS_OV + 52 * MiB, WS_Q1 = WS_OV + 53 * MiB, WS_K1 = WS_OV + 77 * MiB, WS_VT1 = WS_OV + 101 * MiB,
                 WS_ST = WS_OV + 117 * MiB, WS_G = WS_OV + 121 * MiB, WS_MIX = WS_OV + 137 * MiB;
constexpr size_t WS_Q2 = WS_OV, WS_K2 = WS_OV + 32 * MiB, WS_VT2 = WS_OV + 64 * MiB, WS_OA = WS_OV + 96 * MiB, WS_O1S = WS_OV + 128 * MiB;
constexpr size_t WS_END = 289 * MiB;
constexpr int LDS_BYTES = 135168;

__constant__ float INV_M[16] = {1.000000000e+00f, 5.623413252e-01f, 3.162277660e-01f, 1.778279410e-01f, 1.000000000e-01f, 5.623413252e-02f, 3.162277660e-02f, 1.778279410e-02f,
                                1.000000000e-02f, 5.623413252e-03f, 3.162277660e-03f, 1.778279410e-03f, 1.000000000e-03f, 5.623413252e-04f, 3.162277660e-04f, 1.778279410e-04f};
__constant__ float INV_T[8] = {1.000000000e+00f, 1.939227447e-01f, 3.760603093e-02f, 7.292664737e-03f, 1.414213562e-03f, 2.742481757e-04f, 5.318295897e-05f, 1.031338538e-05f};

__device__ __forceinline__ unsigned pk2(float lo, float hi) { f32x2 v = {lo, hi}; bf16x2_t b = __builtin_convertvector(v, bf16x2_t); return __builtin_bit_cast(unsigned, b); }
__device__ __forceinline__ float bf2f(unsigned h) { return __builtin_bit_cast(float, h << 16); }
__device__ __forceinline__ float wave_sum(float v) {
#pragma unroll
    for (int o = 1; o < 64; o <<= 1) v += __shfl_xor(v, o);
    return v;
}
__device__ __forceinline__ void wave_lds_sync() { asm volatile("s_waitcnt lgkmcnt(0)" ::: "memory"); __builtin_amdgcn_wave_barrier(); }
__device__ __forceinline__ float sigmoidf_(float v) { return __builtin_amdgcn_rcpf(1.f + __builtin_amdgcn_exp2f(-v * LOG2E)); }
typedef __attribute__((address_space(1))) void* gvoidp;
__device__ __forceinline__ gvoidp ldptr(const LAS unsigned long long* tab, int i) { const unsigned long long v = tab[i]; const unsigned lo = __builtin_amdgcn_readfirstlane((unsigned)v), hi = __builtin_amdgcn_readfirstlane((unsigned)(v >> 32)); return (gvoidp)(((unsigned long long)hi << 32) | lo); }
__device__ __forceinline__ int swap23(int s) { return (s & ~12) | ((s & 4) << 1) | ((s & 8) >> 1); }

struct EpiSwiglu { static constexpr bool PERM = true, AFTER_DRAIN = false;
    bf16_t* O; const float* ss;
    __device__ __forceinline__ void operator()(const f32x4 (&acc)[2][2][4][2], const Unit& u, int wr, int wc, int fr, int fq) const {
        const int row0 = u.pm * 256 + wr * 64 + fr, col0 = u.pn * 128 + wc * 32 + 8 * fq;
#pragma unroll
        for (int ai = 0; ai < 2; ++ai)
#pragma unroll
            for (int m = 0; m < 4; ++m) { int row = row0 + ai * 128 + m * 16; asm volatile("" : "+v"(row) :: "memory"); const float rs = __builtin_amdgcn_rsqf(ss[row] * (1.f / D_) + EPS);
                float a[8];
#pragma unroll
                for (int n = 0; n < 2; ++n)
#pragma unroll
                    for (int i = 0; i < 4; ++i) { const float g = acc[ai][0][m][n][i] * rs, uu = acc[ai][1][m][n][i] * rs; a[4 * n + i] = g * sigmoidf_(g) * uu; }
                u32x4 w = {pk2(a[0], a[1]), pk2(a[2], a[3]), pk2(a[4], a[5]), pk2(a[6], a[7])};
                *(u32x4*)(O + (size_t)row * FF_ + col0) = w; }
    }
};
struct EpiResid { static constexpr bool PERM = true, AFTER_DRAIN = false;
    const float* Xin; float* Xout; bf16_t* XB; float* ssout; float sc;
    __device__ __forceinline__ void operator()(const f32x4 (&acc)[2][2][4][2], const Unit& u, int wr, int wc, int fr, int fq) const {
        const int row0 = u.pm * 256 + wr * 64 + fr, col0 = u.pn * 256 + wc * 32 + 8 * fq;
#pragma unroll
        for (int ai = 0; ai < 2; ++ai)
#pragma unroll
            for (int m = 0; m < 4; ++m) { int row = row0 + ai * 128 + m * 16; asm volatile("" : "+v"(row) :: "memory"); float sq = 0.f;
#pragma unroll
                for (int bj = 0; bj < 2; ++bj) { const size_t off = (size_t)row * D_ + col0 + bj * 128;
                    f32x4 x0 = *(const f32x4*)(Xin + off), x1 = *(const f32x4*)(Xin + off + 4);
                    x0 = x0 + acc[ai][bj][m][0] * sc; x1 = x1 + acc[ai][bj][m][1] * sc;
                    *(f32x4*)(Xout + off) = x0; *(f32x4*)(Xout + off + 4) = x1;
                    if (XB) { u32x4 w = {pk2(x0[0], x0[1]), pk2(x0[2], x0[3]), pk2(x1[0], x1[1]), pk2(x1[2], x1[3])}; *(u32x4*)(XB + off) = w; }
                    sq += (x0[0] * x0[0] + x0[1] * x0[1]) + (x0[2] * x0[2] + x0[3] * x0[3]) + (x1[0] * x1[0] + x1[1] * x1[1]) + (x1[2] * x1[2] + x1[3] * x1[3]); }
                if (ssout) { sq += __shfl_xor(sq, 16); sq += __shfl_xor(sq, 32); if (fq == 0) atomicAdd(ssout + row, sq); } }
    }
};
__device__ __forceinline__ void rope8(float (&v)[8], f32x4 c4, f32x4 s4) {
#pragma unroll
    for (int e = 0; e < 4; ++e) { const float x1 = v[2 * e], x2 = v[2 * e + 1]; v[2 * e] = x1 * c4[e] - x2 * s4[e]; v[2 * e + 1] = x2 * c4[e] + x1 * s4[e]; }
}
struct EpiEvIn { static constexpr bool PERM = true, AFTER_DRAIN = false;
    const float* ss; float* U; bf16_t* CQ; bf16_t* CKV; bf16_t* KPE; float* ssq; float* sskv; const float* cosm; const float* sinm;
    __device__ __forceinline__ void operator()(const f32x4 (&acc)[2][2][4][2], const Unit& u, int wr, int wc, int fr, int fq) const {
        const int row0 = u.pm * 256 + wr * 64 + fr;
#pragma unroll
        for (int ai = 0; ai < 2; ++ai)
#pragma unroll
            for (int m = 0; m < 4; ++m) { int row = row0 + ai * 128 + m * 16; asm volatile("" : "+v"(row) :: "memory"); const float rs = __builtin_amdgcn_rsqf(ss[row] * (1.f / D_) + EPS);
                float sq = 0.f, skv = 0.f;
#pragma unroll
                for (int bj = 0; bj < 2; ++bj) { const int col = u.pn * 256 + bj * 128 + wc * 32 + 8 * fq;
                    float v[8];
#pragma unroll
                    for (int n = 0; n < 2; ++n)
#pragma unroll
                        for (int i = 0; i < 4; ++i) v[4 * n + i] = acc[ai][bj][m][n][i] * rs;
                    if (col < 512) { float* p = U + (size_t)row * 512 + col; *(f32x4*)p = (f32x4){v[0], v[1], v[2], v[3]}; *(f32x4*)(p + 4) = (f32x4){v[4], v[5], v[6], v[7]}; }
                    else if (col < 896) { u32x4 w = {pk2(v[0], v[1]), pk2(v[2], v[3]), pk2(v[4], v[5]), pk2(v[6], v[7])}; *(u32x4*)(CQ + (size_t)row * 384 + (col - 512)) = w;
#pragma unroll
                        for (int i = 0; i < 8; ++i) sq += v[i] * v[i]; }
                    else if (col < 928) { const int i0 = (col - 896) >> 1;
                        const f32x4 c4 = *(const f32x4*)(cosm + (size_t)row * 16 + i0), s4 = *(const f32x4*)(sinm + (size_t)row * 16 + i0); rope8(v, c4, s4);
                        u32x4 w = {pk2(v[0], v[1]), pk2(v[2], v[3]), pk2(v[4], v[5]), pk2(v[6], v[7])}; *(u32x4*)(KPE + (size_t)row * 32 + (col - 896)) = w; }
                    else if (col >= 1024) { u32x4 w = {pk2(v[0], v[1]), pk2(v[2], v[3]), pk2(v[4], v[5]), pk2(v[6], v[7])}; *(u32x4*)(CKV + (size_t)row * 256 + (col - 1024)) = w;
#pragma unroll
                        for (int i = 0; i < 8; ++i) skv += v[i] * v[i]; } }
                if (u.pn == 2 || u.pn == 3) { sq += __shfl_xor(sq, 16); sq += __shfl_xor(sq, 32); if (fq == 0) atomicAdd(ssq + row, sq); }
                if (u.pn == 4) { skv += __shfl_xor(skv, 16); skv += __shfl_xor(skv, 32); if (fq == 0) atomicAdd(sskv + row, skv); } }
    }
};
struct EpiQ { static constexpr bool PERM = true, AFTER_DRAIN = false;
    const float* ssq; bf16_t* Q1; const float* cosm; const float* sinm;
    __device__ __forceinline__ void operator()(const f32x4 (&acc)[2][2][4][2], const Unit& u, int wr, int wc, int fr, int fq) const {
        const int row0 = u.pm * 256 + wr * 64 + fr;
#pragma unroll
        for (int ai = 0; ai < 2; ++ai)
#pragma unroll
            for (int m = 0; m < 4; ++m) { int row = row0 + ai * 128 + m * 16; asm volatile("" : "+v"(row) :: "memory"); const float rs = __builtin_amdgcn_rsqf(ssq[row] * (1.f / 384.f) + EPS) * QSCALE1;
                const int b = row >> 13, s = row & (S_ - 1);
#pragma unroll
                for (int bj = 0; bj < 2; ++bj) { const int col = u.pn * 256 + bj * 128 + wc * 32 + 8 * fq, h = col / 96, j = col - h * 96;
                    float v[8];
#pragma unroll
                    for (int n = 0; n < 2; ++n)
#pragma unroll
                        for (int i = 0; i < 4; ++i) v[4 * n + i] = acc[ai][bj][m][n][i] * rs;
                    if (j >= 64) { const int i0 = (j - 64) >> 1; const f32x4 c4 = *(const f32x4*)(cosm + (size_t)row * 16 + i0), s4 = *(const f32x4*)(sinm + (size_t)row * 16 + i0); rope8(v, c4, s4); }
                    u32x4 w = {pk2(v[0], v[1]), pk2(v[2], v[3]), pk2(v[4], v[5]), pk2(v[6], v[7])};
                    *(u32x4*)(Q1 + ((size_t)(b * 8 + h) * S_ + s) * 96 + j) = w; } }
    }
};
struct EpiKV { static constexpr bool PERM = true, AFTER_DRAIN = false;
    const float* sskv; bf16_t* K1; bf16_t* VT1; const bf16_t* KPE;
    __device__ __forceinline__ void operator()(const f32x4 (&acc)[2][2][4][2], const Unit& u, int wr, int wc, int fr, int fq) const {
        const int row0 = u.pm * 256 + wr * 64 + fr;
#pragma unroll
        for (int ai = 0; ai < 2; ++ai)
#pragma unroll
            for (int m = 0; m < 4; ++m) { int row = row0 + ai * 128 + m * 16; asm volatile("" : "+v"(row) :: "memory"); const float rs = __builtin_amdgcn_rsqf(sskv[row] * (1.f / 256.f) + EPS);
                const int b = row >> 13, s = row & (S_ - 1);
#pragma unroll
                for (int bj = 0; bj < 2; ++bj) { const int col = u.pn * 256 + bj * 128 + wc * 32 + 8 * fq, h = col >> 7, j = col & 127;
                    float v[8];
#pragma unroll
                    for (int n = 0; n < 2; ++n)
#pragma unroll
                        for (int i = 0; i < 4; ++i) v[4 * n + i] = acc[ai][bj][m][n][i] * rs;
                    if (j < 64) { bf16_t* kp = K1 + ((size_t)(b * 8 + h) * S_ + s) * 96;
                        u32x4 w = {pk2(v[0], v[1]), pk2(v[2], v[3]), pk2(v[4], v[5]), pk2(v[6], v[7])}; *(u32x4*)(kp + j) = w;
                        if (j < 32) *(u32x4*)(kp + 64 + j) = *(const u32x4*)(KPE + (size_t)row * 32 + j); }
                    else { bf16_t* vp = VT1 + (((size_t)(b * 8 + h) * (S_ / 64) + (s >> 6)) * 64 + (j - 64)) * 64 + swap23(s & 63);
#pragma unroll
                        for (int i = 0; i < 8; i += 2) { const unsigned w = pk2(v[i], v[i + 1]); vp[i * 64] = (bf16_t)(w & 0xffffu); vp[(i + 1) * 64] = (bf16_t)(w >> 16); } } } }
    }
};
struct EpiGlu { static constexpr bool PERM = true, AFTER_DRAIN = false;
    const bf16_t* G; const float* bias; bf16_t* MIX;
    __device__ __forceinline__ void operator()(const f32x4 (&acc)[2][2][4][2], const Unit& u, int wr, int wc, int fr, int fq) const {
        const int row0 = u.pm * 256 + wr * 64 + fr;
#pragma unroll
        for (int bj = 0; bj < 2; ++bj) { const int col = u.pn * 256 + bj * 128 + wc * 32 + 8 * fq;
            const f32x4 b0 = *(const f32x4*)(bias + col), b1 = *(const f32x4*)(bias + col + 4);
#pragma unroll
            for (int ai = 0; ai < 2; ++ai)
#pragma unroll
                for (int m = 0; m < 4; ++m) { int row = row0 + ai * 128 + m * 16; asm volatile("" : "+v"(row) :: "memory");
                    const u32x4 gw = *(const u32x4*)(G + (size_t)row * 512 + col);
                    const f32x4 z0 = acc[ai][bj][m][0] + b0, z1 = acc[ai][bj][m][1] + b1; float o[8];
#pragma unroll
                    for (int i = 0; i < 4; ++i) { const unsigned ww = gw[i]; o[2 * i] = bf2f(ww & 0xffffu); o[2 * i + 1] = bf2f(ww >> 16); }
#pragma unroll
                    for (int i = 0; i < 4; ++i) { o[i] *= sigmoidf_(z0[i]); o[4 + i] *= sigmoidf_(z1[i]); }
                    u32x4 w = {pk2(o[0], o[1]), pk2(o[2], o[3]), pk2(o[4], o[5]), pk2(o[6], o[7])};
                    *(u32x4*)(MIX + (size_t)row * D_ + col) = w; } }
    }
};
struct EpiOdIn { static constexpr bool PERM = true, AFTER_DRAIN = false;
    const float* ss; bf16_t* Q2; bf16_t* K2; bf16_t* VT2; const float* cost; const float* sint;
    __device__ __forceinline__ void operator()(const f32x4 (&acc)[2][2][4][2], const Unit& u, int wr, int wc, int fr, int fq) const {
        const int row0 = u.pm * 256 + wr * 64 + fr; const int sec = u.pn >> 2;
#pragma unroll
        for (int ai = 0; ai < 2; ++ai)
#pragma unroll
            for (int m = 0; m < 4; ++m) { int row = row0 + ai * 128 + m * 16; asm volatile("" : "+v"(row) :: "memory"); float rs = __builtin_amdgcn_rsqf(ss[row] * (1.f / D_) + EPS); if (sec == 0) rs *= QSCALE2;
                const int b = row >> 13, s = row & (S_ - 1);
#pragma unroll
                for (int bj = 0; bj < 2; ++bj) { const int cc = (u.pn & 3) * 256 + bj * 128 + wc * 32 + 8 * fq, h = cc >> 7, wi = cc & 127;
                    float v[8];
#pragma unroll
                    for (int n = 0; n < 2; ++n)
#pragma unroll
                        for (int i = 0; i < 4; ++i) v[4 * n + i] = acc[ai][bj][m][n][i] * rs;
                    if (sec < 2) { const int mi = wi >> 6, d = wi & 63;
                        if (d < 16) { const int i0 = d >> 1; const f32x4 c4 = *(const f32x4*)(cost + (size_t)row * 8 + i0), s4 = *(const f32x4*)(sint + (size_t)row * 8 + i0); rope8(v, c4, s4); }
                        u32x4 w = {pk2(v[0], v[1]), pk2(v[2], v[3]), pk2(v[4], v[5]), pk2(v[6], v[7])};
                        bf16_t* base = sec == 0 ? Q2 : K2; *(u32x4*)(base + ((size_t)((b * 8 + h) * 2 + mi) * S_ + s) * 64 + d) = w; }
                    else { bf16_t* vp = VT2 + (((size_t)(b * 8 + h) * (S_ / 64) + (s >> 6)) * 128 + wi) * 64 + swap23(s & 63);
#pragma unroll
                        for (int i = 0; i < 8; i += 2) { const unsigned w = pk2(v[i], v[i + 1]); vp[i * 64] = (bf16_t)(w & 0xffffu); vp[(i + 1) * 64] = (bf16_t)(w >> 16); } } } }
    }
};
__device__ __forceinline__ int perm_src(int n, int mode) {
    if (mode == 1) return (n >> 1) + ((n & 1) << 4);
    if (mode == 2) return n < 16 ? ((n >> 1) + ((n & 1) << 3)) : n;
    return n;
}
__device__ __forceinline__ void tr_item(const float* __restrict__ W, int K, int Ns, int n0s, int pmode, const float* __restrict__ gain, bf16_t* __restrict__ WT, int n0d, int k0, LAS float* scr, int lane) {
    const int c = lane & 7;
    if (n0s < 0) {
#pragma unroll
        for (int j = 0; j < 4; ++j) { const int n = (lane >> 3) + 8 * j; *(u32x4*)(WT + (size_t)(n0d + n) * K + k0 + 8 * c) = (u32x4){0u, 0u, 0u, 0u}; }
        return; }
    float wv[32];
#pragma unroll
    for (int i = 0; i < 32; ++i) wv[i] = W[(size_t)(k0 + 2 * i + (lane >> 5)) * Ns + n0s + (lane & 31)];
#pragma unroll
    for (int i = 0; i < 32; ++i) { const int kk = 2 * i + (lane >> 5); float v = wv[i]; if (gain) v *= gain[k0 + kk]; scr[kk * 33 + (lane & 31)] = v; }
    wave_lds_sync();
#pragma unroll
    for (int j = 0; j < 4; ++j) { const int n = (lane >> 3) + 8 * j; const LAS float* s = scr + (8 * c) * 33 + perm_src(n, pmode);
        u32x4 o; o.x = pk2(s[0 * 33], s[1 * 33]); o.y = pk2(s[2 * 33], s[3 * 33]); o.z = pk2(s[4 * 33], s[5 * 33]); o.w = pk2(s[6 * 33], s[7 * 33]);
        *(u32x4*)(WT + (size_t)(n0d + n) * K + k0 + 8 * c) = o; }
    wave_lds_sync();
}
__device__ __forceinline__ void map_block(int mode, int n0d, int& n0s, int& pm) {
    pm = 0; n0s = n0d;
    if (mode == 1) { const int tile = n0d >> 8, w = n0d & 255; n0s = (w < 128) ? (tile * 128 + w) : (FF_ + tile * 128 + (w - 128)); }
    else if (mode == 2) { if (n0d < 896) n0s = n0d; else if (n0d == 896) { n0s = 1152; pm = 1; } else if (n0d < 1024) n0s = -1; else n0s = n0d - 1024 + 896; }
    else if (mode == 3) { if (((n0d >> 5) % 3) == 2) pm = 1; }
    else if (mode == 4) { if (n0d < 2048 && (n0d & 63) == 0) pm = 2; }
}

struct Args { const void* in[31]; float* out; unsigned char* ws; int ph_lo, ph_hi; };

template <int DK>
__device__ __forceinline__ void attn_qk(f32x16& p0, f32x16& p1, const LAS unsigned char* kb, const bf16x8 (&qf)[DK / 16], int q, int hi) {
    constexpr int KP = DK * 2 + 16;
#pragma unroll
    for (int r = 0; r < 16; ++r) { p0[r] = 0.f; p1[r] = 0.f; }
#pragma unroll
    for (int ks = 0; ks < DK / 16; ++ks) {
        const bf16x8 k0 = *(const LAS bf16x8*)(kb + q * KP + ks * 32 + hi * 16);
        const bf16x8 k1 = *(const LAS bf16x8*)(kb + (32 + q) * KP + ks * 32 + hi * 16);
        p0 = __builtin_amdgcn_mfma_f32_32x32x16_bf16(k0, qf[ks], p0, 0, 0, 0);
        p1 = __builtin_amdgcn_mfma_f32_32x32x16_bf16(k1, qf[ks], p1, 0, 0, 0);
    }
}
template <int DV>
__device__ __forceinline__ void attn_prep(f32x16& p0, f32x16& p1, f32x16 (&o)[DV / 32], float& mhat, float& lrun, f32x16& negm, bool first, int jb, int w, int q, int hi) {
    if (jb >= 0) { const int kvb = 64 * jb + 4 * hi, qrel = 32 * w + q;
#pragma unroll
        for (int r = 0; r < 16; ++r) { const int kv = kvb + (r & 3) + 8 * (r >> 2); if (kv > qrel) p0[r] = -INFINITY; if (kv + 32 > qrel) p1[r] = -INFINITY; } }
    float tm = fmaxf(p0[0], p1[0]);
#pragma unroll
    for (int r = 1; r < 16; ++r) tm = fmaxf(tm, fmaxf(p0[r], p1[r]));
    { auto rr = __builtin_amdgcn_permlane32_swap(__float_as_uint(tm), __float_as_uint(tm), false, false); tm = fmaxf(__uint_as_float(rr[0]), __uint_as_float(rr[1])); }
    if (first || __any(tm > 6.f)) { const float delta = first ? tm : fmaxf(tm, 0.f), alpha = first ? 1.f : __builtin_amdgcn_exp2f(-delta); mhat += delta; lrun *= alpha;
#pragma unroll
        for (int r = 0; r < 16; ++r) { p0[r] -= delta; p1[r] -= delta; negm[r] = -mhat; }
#pragma unroll
        for (int blk = 0; blk < DV / 32; ++blk)
#pragma unroll
            for (int r = 0; r < 16; ++r) o[blk][r] *= alpha; }
}
template <int DV>
__device__ __forceinline__ void attn_exp_pv(const f32x16& p0, const f32x16& p1, f32x16 (&o)[DV / 32], float mhat, float& lrun, const LAS unsigned char* vb, int q, int hi) {
    constexpr int VP = 144;
    float ls = 0.f;
#pragma unroll
    for (int j = 0; j < 4; ++j) { float e[8];
#pragma unroll
        for (int i = 0; i < 8; ++i) { const float sv = (j < 2) ? p0[8 * (j & 1) + i] : p1[8 * (j & 1) + i]; e[i] = __builtin_amdgcn_exp2f(sv - mhat); }
        ls += ((e[0] + e[1]) + (e[2] + e[3])) + ((e[4] + e[5]) + (e[6] + e[7]));
        u32x4 pa = {pk2(e[0], e[1]), pk2(e[2], e[3]), pk2(e[4], e[5]), pk2(e[6], e[7])}; const bf16x8 pw = __builtin_bit_cast(bf16x8, pa);
#pragma unroll
        for (int blk = 0; blk < DV / 32; ++blk) { const bf16x8 a = *(const LAS bf16x8*)(vb + (32 * blk + q) * VP + (16 * j + 8 * hi) * 2);
            o[blk] = __builtin_amdgcn_mfma_f32_32x32x16_bf16(a, pw, o[blk], 0, 0, 0); } }
    lrun += ls;
}
template <int DK, int DV>
__device__ __forceinline__ void attn_fused(f32x16& n0, f32x16& n1, const f32x16& p0, const f32x16& p1, f32x16 (&o)[DV / 32], float mhat, float& lrun, const LAS unsigned char* kb, const LAS unsigned char* vb,
                                           const bf16x8 (&qf)[DK / 16], const f32x16& negm, int q, int hi) {
    constexpr int KP = DK * 2 + 16, VP = 144, NKS = DK / 16, NB = DV / 32;
    constexpr int KMAX = (NKS + 3) / 4;
    constexpr bool PFV = DV <= 64;
    n0 = negm; n1 = negm;
    float ls = 0.f;
    bf16x8 kc0[KMAX], kc1[KMAX], vc[NB], kn0[KMAX], kn1[KMAX], vn[NB];
#define ATT_RD_SLICE(j, k0a, k1a, va) do { _Pragma("unroll") for (int i_ = 0; i_ < KMAX; ++i_) { const int ks_ = ((j) * NKS) / 4 + i_; if (ks_ < (((j) + 1) * NKS) / 4) { \
            if (PFV) { k0a[i_] = *(const LAS bf16x8*)(kb + q * KP + ks_ * 32 + hi * 16); k1a[i_] = *(const LAS bf16x8*)(kb + (32 + q) * KP + ks_ * 32 + hi * 16); } } } \
        if (PFV) { _Pragma("unroll") for (int blk_ = 0; blk_ < NB; ++blk_) va[blk_] = *(const LAS bf16x8*)(vb + (32 * blk_ + q) * VP + (16 * (j) + 8 * hi) * 2); } } while (0)
    ATT_RD_SLICE(0, kc0, kc1, vc);
#pragma unroll
    for (int j = 0; j < 4; ++j) {
        if (j < 3) ATT_RD_SLICE(j + 1, kn0, kn1, vn);
#pragma unroll
        for (int i = 0; i < KMAX; ++i) { const int ks = (j * NKS) / 4 + i; if (ks < ((j + 1) * NKS) / 4) {
            const bf16x8 ka_ = PFV ? kc0[i] : *(const LAS bf16x8*)(kb + q * KP + ks * 32 + hi * 16), kb_ = PFV ? kc1[i] : *(const LAS bf16x8*)(kb + (32 + q) * KP + ks * 32 + hi * 16);
            n0 = __builtin_amdgcn_mfma_f32_32x32x16_bf16(ka_, qf[ks], n0, 0, 0, 0);
            n1 = __builtin_amdgcn_mfma_f32_32x32x16_bf16(kb_, qf[ks], n1, 0, 0, 0); } }
        float e[8];
#pragma unroll
        for (int i = 0; i < 8; ++i) { const float sv = (j < 2) ? p0[8 * (j & 1) + i] : p1[8 * (j & 1) + i]; e[i] = __builtin_amdgcn_exp2f(sv); }
        ls += ((e[0] + e[1]) + (e[2] + e[3])) + ((e[4] + e[5]) + (e[6] + e[7]));
        u32x4 pa = {pk2(e[0], e[1]), pk2(e[2], e[3]), pk2(e[4], e[5]), pk2(e[6], e[7])}; const bf16x8 pw = __builtin_bit_cast(bf16x8, pa);
#pragma unroll
        for (int blk = 0; blk < NB; ++blk) { const bf16x8 va_ = PFV ? vc[blk] : *(const LAS bf16x8*)(vb + (32 * blk + q) * VP + (16 * j + 8 * hi) * 2);
            o[blk] = __builtin_amdgcn_mfma_f32_32x32x16_bf16(va_, pw, o[blk], 0, 0, 0); }
        __builtin_amdgcn_sched_barrier(0);
        if (j < 3) {
#pragma unroll
            for (int i = 0; i < KMAX; ++i) if (PFV) { kc0[i] = kn0[i]; kc1[i] = kn1[i]; }
#pragma unroll
            for (int blk = 0; blk < NB; ++blk) if (PFV) vc[blk] = vn[blk]; }
    }
#undef ATT_RD_SLICE
    lrun += ls;
}
template <int DK, int DV>
__device__ __forceinline__ void attn_unit(const bf16_t* __restrict__ Qh, const bf16_t* __restrict__ Kh, const bf16_t* __restrict__ Vth, int qb, LAS unsigned char* lds, f32x16 (&o)[DV / 32]) {
    constexpr int KP = DK * 2 + 16, VP = 144, KBYTES = 64 * KP, VBYTES = DV * VP, VOFF = 2 * KBYTES;
    constexpr int KC = DK / 8, KCH = 64 * KC, KN = (KCH + 511) / 512, VN = DV * 8 / 512;
    const int tid = opaque_tid(), lane = tid & 63, w = __builtin_amdgcn_readfirstlane(tid >> 6), q = lane & 31, hi = lane >> 5;
    bf16x8 qf[DK / 16];
    { const bf16_t* qp = Qh + (size_t)(qb * 256 + w * 32 + q) * DK + hi * 8;
#pragma unroll
      for (int ks = 0; ks < DK / 16; ++ks) qf[ks] = *(const bf16x8*)(qp + ks * 16); }
#pragma unroll
    for (int blk = 0; blk < DV / 32; ++blk)
#pragma unroll
        for (int r = 0; r < 16; ++r) o[blk][r] = 0.f;
    float mhat = 0.f, lrun = 0.f;
    f32x16 negm;
#pragma unroll
    for (int r = 0; r < 16; ++r) negm[r] = 0.f;
    const int NT = 4 * qb + 4, NTw = NT - 3 + (w >> 1);
    constexpr int DUMMY_OFF = 2 * KBYTES + 2 * VBYTES;
    const int dummy = DUMMY_OFF + tid * 16;
    int kl[KN], vl[VN]; unsigned kg[KN];
#pragma unroll
    for (int i = 0; i < KN; ++i) { const int c = tid + 512 * i; const bool ok = c < KCH; const int cc = ok ? c : KCH - 1; kl[i] = ok ? (cc / KC) * KP + (cc % KC) * 16 : -1; kg[i] = (unsigned)cc * 8u; }
#pragma unroll
    for (int i = 0; i < VN; ++i) { const int c = tid + 512 * i, d = c >> 3, cc = c & 7; vl[i] = VOFF + d * VP + cc * 16; }
    u32x4 kra[KN], vra[VN], krb[KN], vrb[VN];
#define ATT_GLOAD_K(t, kr) do { const int tt_ = (t) < NT ? (t) : NT - 1; _Pragma("unroll") for (int i_ = 0; i_ < KN; ++i_) kr[i_] = *(const u32x4*)(Kh + (size_t)tt_ * 64 * DK + kg[i_]); } while (0)
#define ATT_GLOAD_V(t, vr) do { const int tt_ = (t) < NT ? (t) : NT - 1; _Pragma("unroll") for (int i_ = 0; i_ < VN; ++i_) vr[i_] = *(const u32x4*)(Vth + (size_t)tt_ * (DV * 64) + (size_t)(tid + 512 * i_) * 8); } while (0)
#define ATT_LSTORE_K(slot, kr, valid) do { _Pragma("unroll") for (int i_ = 0; i_ < KN; ++i_) { const int a_ = ((valid) && kl[i_] >= 0) ? (slot) * KBYTES + kl[i_] : dummy; *(LAS u32x4*)(lds + a_) = kr[i_]; } } while (0)
#define ATT_LSTORE_V(slot, vr, valid) do { _Pragma("unroll") for (int i_ = 0; i_ < VN; ++i_) { const int a_ = (valid) ? (slot) * VBYTES + vl[i_] : dummy; *(LAS u32x4*)(lds + a_) = vr[i_]; } } while (0)
    ATT_GLOAD_K(0, kra); ATT_GLOAD_V(0, vra); ATT_GLOAD_K(1, krb); ATT_LSTORE_K(0, kra, true); ATT_LSTORE_V(0, vra, true); ATT_LSTORE_K(1, krb, true);
    ATT_GLOAD_K(2, krb); ATT_GLOAD_V(1, vrb);
    __syncthreads();
    f32x16 sa0, sa1, sb0, sb1;
    attn_qk<DK>(sa0, sa1, lds, qf, q, hi);
    asm volatile("s_waitcnt lgkmcnt(0)\n\ts_barrier" ::: "memory");
#define ATT_STAGE_LD(t, krl, vrl) do { ATT_GLOAD_K((t) + 3, krl); ATT_GLOAD_V((t) + 2, vrl); } while (0)
#define ATT_STAGE_ST(t, par, krs, vrs) do { ATT_LSTORE_K(par, krs, (t) + 2 < NT); ATT_LSTORE_V((par) ^ 1, vrs, (t) + 1 < NT); } while (0)
#define ATT_BAR() asm volatile("s_waitcnt lgkmcnt(0)\n\ts_barrier" ::: "memory")
#define ATT_STEP(t, c0, c1, n0, n1, par, krl, vrl, krs, vrs) do { \
        ATT_STAGE_LD(t, krl, vrl); \
        attn_prep<DV>(c0, c1, o, mhat, lrun, negm, (t) == 0, (t) - (NT - 4), w, q, hi); \
        attn_fused<DK, DV>(n0, n1, c0, c1, o, mhat, lrun, lds + ((par) ^ 1) * KBYTES, lds + VOFF + (par) * VBYTES, qf, negm, q, hi); \
        ATT_STAGE_ST(t, par, krs, vrs); \
        ATT_BAR(); } while (0)
    const int NTw2 = (NTw + 1) & ~1;
    int t = 0;
    for (; t < NTw2; t += 2) {
        ATT_STEP(t, sa0, sa1, sb0, sb1, 0, kra, vra, krb, vrb);
        ATT_STEP(t + 1, sb0, sb1, sa0, sa1, 1, krb, vrb, kra, vra);
    }
    for (; t < NT; t += 2) {
        ATT_STAGE_LD(t, kra, vra); ATT_STAGE_ST(t, 0, krb, vrb); ATT_BAR();
        ATT_STAGE_LD(t + 1, krb, vrb); ATT_STAGE_ST(t + 1, 1, kra, vra); ATT_BAR();
    }
#undef ATT_STAGE_LD
#undef ATT_STAGE_ST
#undef ATT_STEP
#undef ATT_GLOAD_K
#undef ATT_GLOAD_V
#undef ATT_LSTORE_K
#undef ATT_LSTORE_V
    { auto rr = __builtin_amdgcn_permlane32_swap(__float_as_uint(lrun), __float_as_uint(lrun), false, false); lrun = __uint_as_float(rr[0]) + __uint_as_float(rr[1]); }
    const float inv = 1.f / lrun;
#pragma unroll
    for (int blk = 0; blk < DV / 32; ++blk)
#pragma unroll
        for (int r = 0; r < 16; ++r) o[blk][r] *= inv;
}


__device__ __forceinline__ f32x2 cmadd(f32x2 a, f32x2 x, f32x2 b) { f32x2 r; r.x = a.x * x.x - a.y * x.y + b.x; r.y = a.x * x.y + a.y * x.x + b.y; return r; }
template <bool PASSC>
__device__ __forceinline__ void s5_pass(LAS unsigned char* lds, const float* __restrict__ U, const f32x2* __restrict__ AB, const f32x2* __restrict__ ABL, const f32x2* __restrict__ BB, f32x2* ST,
                                        const float* __restrict__ c_re, const float* __restrict__ c_im, const float* __restrict__ dsk, bf16_t* Gout, int gw, int NGW, int w, int lane) {
    LAS float* ut = (LAS float*)(lds + w * 8448);
    LAS bf16_t* xt = (LAS bf16_t*)(lds + w * 8448 + 4096);
    for (int it = gw; it < 8192; it += NGW) {
        const int bg = it >> 7, c = ((it & 127) + 32 * (it >> 11)) & 127, b = bg >> 5, g = bg & 31;
        const int e = g * 64 + lane;
        const f32x2 ab = AB[e];
        f32x2 bb[16];
        { const f32x4* bp = (const f32x4*)(BB + (size_t)e * 16);
#pragma unroll
          for (int i = 0; i < 8; ++i) { const f32x4 v = bp[i]; bb[2 * i] = (f32x2){v[0], v[1]}; bb[2 * i + 1] = (f32x2){v[2], v[3]}; } }
        const float* up = U + (size_t)(b * S_ + c * 64) * 512 + g * 16;
#pragma unroll
        for (int j = 0; j < 4; ++j) { const int row = (lane >> 2) + 16 * j; const f32x4 v = *(const f32x4*)(up + (size_t)row * 512 + (lane & 3) * 4); *(LAS f32x4*)(ut + row * 16 + (lane & 3) * 4) = v; }
        f32x2 x = {0.f, 0.f};
        bf16x8 cfr[4]; f32x4 dsk4 = {0.f, 0.f, 0.f, 0.f};
        if (PASSC) {
            const f32x2 al = ABL[e]; const f32x2* sp = ST + (size_t)bg * 128 * 64 + lane;
            int j = 0;
            for (; j + 8 <= c; j += 8) { f32x2 sv[8];
#pragma unroll
                for (int i = 0; i < 8; ++i) sv[i] = sp[(size_t)(j + i) * 64];
#pragma unroll
                for (int i = 0; i < 8; ++i) x = cmadd(al, x, sv[i]); }
            for (; j < c; ++j) { const f32x2 s = sp[(size_t)j * 64]; x = cmadd(al, x, s); }
            const int h = lane & 15, kq = lane >> 4;
#pragma unroll
            for (int ks = 0; ks < 4; ++ks) { const float* cp = ((ks < 2) ? c_re : c_im) + (size_t)(g * 16 + h) * 64 + 32 * (ks & 1) + 8 * kq; const float sg = (ks < 2) ? 1.f : -1.f;
                const f32x4 v0 = *(const f32x4*)cp * sg, v1 = *(const f32x4*)(cp + 4) * sg;
                u32x4 wv = {pk2(v0[0], v0[1]), pk2(v0[2], v0[3]), pk2(v1[0], v1[1]), pk2(v1[2], v1[3])}; cfr[ks] = __builtin_bit_cast(bf16x8, wv); }
            dsk4 = *(const f32x4*)(dsk + g * 16 + 4 * kq);
        }
        wave_lds_sync();
        for (int sub = 0; sub < 4; ++sub) {
            for (int t4 = 0; t4 < 16; t4 += 4) {
                f32x4 uv[4][4];
#pragma unroll
                for (int a_ = 0; a_ < 4; ++a_) { const LAS f32x4* ur = (const LAS f32x4*)(ut + (sub * 16 + t4 + a_) * 16);
#pragma unroll
                    for (int k = 0; k < 4; ++k) uv[a_][k] = ur[k]; }
#pragma unroll
                for (int a_ = 0; a_ < 4; ++a_) { f32x2 bq[4];
#pragma unroll
                    for (int k = 0; k < 4; ++k) { bq[k] = bb[4 * k] * uv[a_][k][0];
#pragma unroll
                        for (int i = 1; i < 4; ++i) bq[k] = bq[k] + bb[4 * k + i] * uv[a_][k][i]; }
                    const f32x2 bu = (bq[0] + bq[1]) + (bq[2] + bq[3]);
                    x = cmadd(ab, x, bu);
                    if (PASSC) { const int tt = t4 + a_; const unsigned wv = pk2(x.x, x.y); xt[tt * 136 + lane] = (bf16_t)(wv & 0xffffu); xt[tt * 136 + 64 + lane] = (bf16_t)(wv >> 16); } } }
            if (PASSC) {
                wave_lds_sync();
                f32x4 acc = {0.f, 0.f, 0.f, 0.f};
#pragma unroll
                for (int ks = 0; ks < 4; ++ks) { const bf16x8 bx = *(const LAS bf16x8*)(xt + (lane & 15) * 136 + 32 * ks + 8 * (lane >> 4));
                    acc = __builtin_amdgcn_mfma_f32_16x16x32_bf16(cfr[ks], bx, acc, 0, 0, 0); }
                const int tl = sub * 16 + (lane & 15), kq = lane >> 4;
                const f32x4 uu = *(const LAS f32x4*)(ut + tl * 16 + 4 * kq);
                float gv[4];
#pragma unroll
                for (int i = 0; i < 4; ++i) { const float y = acc[i] + dsk4[i] * uu[i]; const float z = 0.7978845608028654f * (y + 0.044715f * y * y * y);
                    gv[i] = y * __builtin_amdgcn_rcpf(1.f + __builtin_amdgcn_exp2f(-2.f * LOG2E * z)); }
                u32x2 wv = {pk2(gv[0], gv[1]), pk2(gv[2], gv[3])};
                *(u32x2*)(Gout + (size_t)(b * S_ + c * 64 + tl) * 512 + g * 16 + 4 * kq) = wv;
                wave_lds_sync();
            }
        }
        if (!PASSC) ST[((size_t)bg * 128 + c) * 64 + lane] = x;
        wave_lds_sync();
    }
}
constexpr size_t WS_BAR = 640 * 1024, BAR_ZERO_BYTES = 16 * 1024;
#define XB_TMO      128
#define XB_XCNT(j)  (256  + 64 * (j))
#define XB_XSUB(j)  (1280 + 64 * (j))
#define XB_XGEN(j)  (2304 + 64 * (j))
#define XB_TOP      3328
#define XB_TOPGEN   3392
#define XCD_BAR_WORDS 3456
#define XB_SPIN_CAP (1u << 18)

__device__ __forceinline__ unsigned xb_ld(unsigned* p)              { return __hip_atomic_load(p, __ATOMIC_RELAXED, __HIP_MEMORY_SCOPE_AGENT); }
__device__ __forceinline__ unsigned xb_add(unsigned* p, unsigned v) { return __hip_atomic_fetch_add(p, v, __ATOMIC_RELAXED, __HIP_MEMORY_SCOPE_AGENT); }
__device__ __forceinline__ unsigned xb_xcc_id() { return (unsigned)__builtin_amdgcn_s_getreg((3 << 11) | 20) & 0xFu; }
#define XB_SPIN(cond, bar) do { unsigned _sp = 0; while (cond) { __builtin_amdgcn_s_sleep(1); \
    if ((++_sp & 255u) == 0u) { if (xb_ld(&(bar)[XB_TMO])) break; if (_sp > XB_SPIN_CAP) { atomicAdd(&(bar)[XB_TMO], 1u); break; } } } } while (0)

struct XcdBarrier {
    unsigned* bar; unsigned x;
    volatile LAS unsigned* st;
};

__device__ __forceinline__ XcdBarrier xcd_barrier_post(unsigned* bar, volatile LAS unsigned* st) {
    XcdBarrier b; b.bar = bar; b.x = xb_xcc_id(); b.st = st;
    if (threadIdx.x == 0) (void)xb_add(&bar[XB_XCNT(b.x)], 1u);
    return b;
}
__device__ __forceinline__ void xcd_barrier_complete(unsigned* bar, unsigned x, unsigned& nloc, unsigned& nx) {
    const unsigned G = gridDim.x * gridDim.y * gridDim.z;
    unsigned sum, cnt, mine, sp = 0u;
    for (;;) {
        sum = 0u; cnt = 0u; mine = 0u;
#pragma unroll
        for (unsigned j = 0; j < 16; ++j) { const unsigned c = xb_ld(&bar[XB_XCNT(j)]); sum += c; cnt += (c > 0u) ? 1u : 0u; mine = (j == x) ? c : mine; }
        if (sum == G) break;
        __builtin_amdgcn_s_sleep(1);
        if ((++sp & 255u) == 0u) { if (xb_ld(&bar[XB_TMO])) break; if (sp > XB_SPIN_CAP) { atomicAdd(&bar[XB_TMO], 1u); break; } }
    }
    nloc = mine > 0u ? mine : 1u; nx = cnt > 0u ? cnt : 1u;
}

__device__ __forceinline__ void xcd_barrier(const XcdBarrier& b) {
    asm volatile("s_waitcnt vmcnt(0)" ::: "memory");
    __syncthreads();
    if (threadIdx.x == 0) {
        unsigned* bar = b.bar;
        __builtin_amdgcn_s_waitcnt(0);
        unsigned nloc = b.st[0], nx = b.st[1];
        if (nloc == 0u) { xcd_barrier_complete(bar, b.x, nloc, nx); b.st[0] = nloc; b.st[1] = nx; }
        const unsigned old = xb_add(&bar[XB_XSUB(b.x)], 1u);
        const unsigned gen = old / nloc;
        if (old + 1u == (gen + 1u) * nloc) {
            __builtin_amdgcn_fence(__ATOMIC_RELEASE, "agent");
            asm volatile("s_waitcnt vmcnt(0)" ::: "memory");
            const unsigned og = xb_add(&bar[XB_TOP], 1u);
            const unsigned tg = og / nx;
            if (og + 1u == (tg + 1u) * nx) xb_add(&bar[XB_TOPGEN], 1u);
            else XB_SPIN(xb_ld(&bar[XB_TOPGEN]) == tg, bar);
            __builtin_amdgcn_fence(__ATOMIC_ACQUIRE, "agent");
            xb_add(&bar[XB_XGEN(b.x)], 1u);
            asm volatile("s_waitcnt vmcnt(0)" ::: "memory");
        } else {
            XB_SPIN(xb_ld(&bar[XB_XGEN(b.x)]) == gen, bar);
            __builtin_amdgcn_fence(__ATOMIC_ACQUIRE, "agent");
            asm volatile("s_waitcnt vmcnt(0)" ::: "memory");
        }
    }
    __syncthreads();
}

constexpr int N_PHASES = 18;
#ifndef PHMASK
#define PHMASK 0x1fffff
#endif
#define EN(p) (((PHMASK) >> (p)) & 1)
#ifndef REP_FFNA
#define REP_FFNA 1
#endif
#ifndef REP_P0
#define REP_P0 1
#endif
#ifndef REP_S5A
#define REP_S5A 1
#endif
#ifndef REP_SYNC
#define REP_SYNC 1
#endif
#ifndef REP_MLA
#define REP_MLA 1
#endif
#ifndef REP_DIFF
#define REP_DIFF 1
#endif
#ifndef REP_S5C
#define REP_S5C 1
#endif
__global__ void __launch_bounds__(512) mega_fwd(Args a) {
    extern __shared__ __attribute__((aligned(16))) unsigned char lds_raw[];
    LAS unsigned char* lds = (LAS unsigned char*)lds_raw;
    const int G = gridDim.x, bx = blockIdx.x, vcu = (G % 8 == 0) ? (bx % 8) * (G / 8) + bx / 8 : bx;
    LAS unsigned long long* ptab = (LAS unsigned long long*)(lds + 131072);
    if (threadIdx.x == 0) {
        ptab[0] = (unsigned long long)a.in[0];
        ptab[1] = (unsigned long long)a.in[1];
        ptab[2] = (unsigned long long)a.in[2];
        ptab[3] = (unsigned long long)a.in[3];
        ptab[4] = (unsigned long long)a.in[4];
        ptab[5] = (unsigned long long)a.in[5];
        ptab[6] = (unsigned long long)a.in[6];
        ptab[7] = (unsigned long long)a.in[7];
        ptab[8] = (unsigned long long)a.in[8];
        ptab[9] = (unsigned long long)a.in[9];
        ptab[10] = (unsigned long long)a.in[10];
        ptab[11] = (unsigned long long)a.in[11];
        ptab[12] = (unsigned long long)a.in[12];
        ptab[13] = (unsigned long long)a.in[13];
        ptab[14] = (unsigned long long)a.in[14];
        ptab[15] = (unsigned long long)a.in[15];
        ptab[16] = (unsigned long long)a.in[16];
        ptab[17] = (unsigned long long)a.in[17];
        ptab[18] = (unsigned long long)a.in[18];
        ptab[19] = (unsigned long long)a.in[19];
        ptab[20] = (unsigned long long)a.in[20];
        ptab[21] = (unsigned long long)a.in[21];
        ptab[22] = (unsigned long long)a.in[22];
        ptab[23] = (unsigned long long)a.in[23];
        ptab[24] = (unsigned long long)a.in[24];
        ptab[25] = (unsigned long long)a.in[25];
        ptab[26] = (unsigned long long)a.in[26];
        ptab[27] = (unsigned long long)a.in[27];
        ptab[28] = (unsigned long long)a.in[28];
        ptab[29] = (unsigned long long)a.in[29];
        ptab[30] = (unsigned long long)a.in[30];
        ptab[31] = (unsigned long long)a.out; ptab[32] = (unsigned long long)a.ws;
        ((LAS unsigned*)(lds + 131072 + 768))[0] = 0u; ((LAS unsigned*)(lds + 131072 + 768))[1] = 0u; }
    __syncthreads();
    const XcdBarrier xbar = xcd_barrier_post((unsigned*)(a.ws + WS_BAR), (volatile LAS unsigned*)(lds + 131072 + 768));
#define LDP_(i) ldptr(ptab, (i))
#define x_in ((const float*)LDP_(0))
#define positions ((const int*)LDP_(1))
#define ffn_norm ((const float*)LDP_(2))
#define ffn_w_gu ((const float*)LDP_(3))
#define ffn_w_down ((const float*)LDP_(4))
#define ev_norm ((const float*)LDP_(5))
#define ev_w_in ((const float*)LDP_(6))
#define s5_lre ((const float*)LDP_(7))
#define s5_lim ((const float*)LDP_(8))
#define s5_logdt ((const float*)LDP_(9))
#define s5_bre ((const float*)LDP_(10))
#define s5_bim ((const float*)LDP_(11))
#define s5_cre ((const float*)LDP_(12))
#define s5_cim ((const float*)LDP_(13))
#define s5_d ((const float*)LDP_(14))
#define s5_wglu ((const float*)LDP_(15))
#define s5_bglu ((const float*)LDP_(16))
#define q_norm ((const float*)LDP_(17))
#define w_uq ((const float*)LDP_(18))
#define kv_norm ((const float*)LDP_(19))
#define w_ukv ((const float*)LDP_(20))
#define ev_w_out ((const float*)LDP_(21))
#define od_norm ((const float*)LDP_(22))
#define od_w_in ((const float*)LDP_(23))
#define lq1 ((const float*)LDP_(24))
#define lk1 ((const float*)LDP_(25))
#define lq2 ((const float*)LDP_(26))
#define lk2 ((const float*)LDP_(27))
#define subln ((const float*)LDP_(28))
#define od_w_out ((const float*)LDP_(29))
#define final_norm ((const float*)LDP_(30))
#define OUT ((float*)LDP_(31))
#define SS ((float*)(ws + (WS_SS)))
#define AB ((f32x2*)(ws + (WS_S5P)))
#define ABL ((f32x2*)(ws + (WS_S5P + 2048 * 8)))
#define BB ((f32x2*)(ws + (WS_S5P + 4096 * 8)))
#define COSM ((float*)(ws + (WS_ROPE)))
#define SINM ((float*)(ws + (WS_ROPE + T_ * 16 * 4)))
#define COST ((float*)(ws + (WS_ROPE + T_ * 32 * 4)))
#define SINT ((float*)(ws + (WS_ROPE + T_ * 40 * 4)))
#define WGU ((bf16_t*)(ws + (WS_WGU)))
#define WD ((bf16_t*)(ws + (WS_WD)))
#define WEVIN ((bf16_t*)(ws + (WS_WEVIN)))
#define WUQ ((bf16_t*)(ws + (WS_WUQ)))
#define WUKV ((bf16_t*)(ws + (WS_WUKV)))
#define WGLU ((bf16_t*)(ws + (WS_WGLU)))
#define WEVOUT ((bf16_t*)(ws + (WS_WEVOUT)))
#define WODIN ((bf16_t*)(ws + (WS_WODIN)))
#define WODOUT ((bf16_t*)(ws + (WS_WODOUT)))
#define XB ((bf16_t*)(ws + (WS_XB)))
#define ACT ((bf16_t*)(ws + (WS_ACT)))
#define U ((float*)(ws + (WS_U)))
#define CQ ((bf16_t*)(ws + (WS_CQ)))
#define CKV ((bf16_t*)(ws + (WS_CKV)))
#define KPE ((bf16_t*)(ws + (WS_KPE)))
#define Q1 ((bf16_t*)(ws + (WS_Q1)))
#define K1 ((bf16_t*)(ws + (WS_K1)))
#define VT1 ((bf16_t*)(ws + (WS_VT1)))
#define ST ((f32x2*)(ws + (WS_ST)))
#define GB ((bf16_t*)(ws + (WS_G)))
#define MIX ((bf16_t*)(ws + (WS_MIX)))
#define Q2 ((bf16_t*)(ws + (WS_Q2)))
#define K2 ((bf16_t*)(ws + (WS_K2)))
#define VT2 ((bf16_t*)(ws + (WS_VT2)))
#define OA ((bf16_t*)(ws + (WS_OA)))
    for (int ph = a.ph_lo; ph < a.ph_hi; ++ph) {
#define TIDVARS const int tid = opaque_tid(), lane = tid & 63, w = __builtin_amdgcn_readfirstlane(tid >> 6), gw = vcu * 8 + w, gt = bx * 512 + tid; (void)lane; (void)gw; (void)gt
        unsigned char* const ws = (unsigned char*)LDP_(32);
        int Gv = G; asm volatile("" : "+s"(Gv)); const int NGW = Gv * 8, NGT = Gv * 512;
        const bool ffn_a = (ph == 1 || ph == 8 || ph == 10 || ph == 15), ffn_b = (ph == 2 || ph == 9 || ph == 11 || ph == 16);
        if (EN(0) && ph == 0) { for (int rep0_ = 0; rep0_ < REP_P0; ++rep0_) { TIDVARS;
            for (int i = gt; i < 7 * T_; i += NGT) SS[T_ + i] = 0.f;
            LAS float* scr = (LAS float*)(lds + w * 8448);
            constexpr int I_GU = 16 * 176, I_D = 44 * 32, I_EVIN = 16 * 40, I_UQ = 6 * 24, I_UKV = 4 * 32, I_GLU = 8 * 16, I_SQ = 16 * 32, I_ODIN = 16 * 96;
            constexpr int NITEMS = 4 * I_GU + 4 * I_D + I_EVIN + I_UQ + I_UKV + I_GLU + I_SQ + I_ODIN + I_SQ;
            for (int it = gw; it < NITEMS; it += NGW) {
                int r = it; const float* W; const float* gain = nullptr; bf16_t* WT; int K, Ns, Nd, mode = 0;
                if (r < 4 * I_GU) { const int i = r / I_GU; r -= i * I_GU; W = ffn_w_gu + (size_t)i * D_ * 2 * FF_; gain = ffn_norm + i * D_; WT = WGU + (size_t)i * 2 * FF_ * D_; K = D_; Ns = 2 * FF_; Nd = 2 * FF_; mode = 1; }
                else if ((r -= 4 * I_GU) < 4 * I_D) { const int i = r / I_D; r -= i * I_D; W = ffn_w_down + (size_t)i * FF_ * D_; WT = WD + (size_t)i * D_ * FF_; K = FF_; Ns = D_; Nd = D_; }
                else if ((r -= 4 * I_D) < I_EVIN) { W = ev_w_in; gain = ev_norm; WT = WEVIN; K = D_; Ns = 1184; Nd = 1280; mode = 2; }
                else if ((r -= I_EVIN) < I_UQ) { W = w_uq; gain = q_norm; WT = WUQ; K = 384; Ns = 768; Nd = 768; mode = 3; }
                else if ((r -= I_UQ) < I_UKV) { W = w_ukv; gain = kv_norm; WT = WUKV; K = 256; Ns = 1024; Nd = 1024; }
                else if ((r -= I_UKV) < I_GLU) { W = s5_wglu; WT = WGLU; K = 512; Ns = 512; Nd = 512; }
                else if ((r -= I_GLU) < I_SQ) { W = ev_w_out; WT = WEVOUT; K = D_; Ns = D_; Nd = D_; }
                else if ((r -= I_SQ) < I_ODIN) { W = od_w_in; gain = od_norm; WT = WODIN; K = D_; Ns = 3072; Nd = 3072; mode = 4; }
                else { r -= I_ODIN; W = od_w_out; WT = WODOUT; K = D_; Ns = D_; Nd = D_; }
                const int NB = Nd / 32, kb = r / NB, nb = r - kb * NB; int n0s, pm; map_block(mode, nb * 32, n0s, pm);
                tr_item(W, K, Ns, n0s, pm, gain, WT, nb * 32, kb * 64, scr, lane);
            }
            for (int m = gw; m < T_; m += NGW) { const f32x4* xr = (const f32x4*)(x_in + (size_t)m * D_) + lane; float s = 0.f;
#pragma unroll
                for (int j = 0; j < 4; ++j) { const f32x4 v = xr[64 * j]; s += (v[0] * v[0] + v[1] * v[1]) + (v[2] * v[2] + v[3] * v[3]);
                    u32x2 o = {pk2(v[0], v[1]), pk2(v[2], v[3])}; *(u32x2*)(XB + (size_t)m * D_ + (64 * j + lane) * 4) = o; }
                s = wave_sum(s); if (lane == 0) SS[m] = s; }
            for (int e = gt; e < T_ * 24; e += NGT) { const bool mm = e < T_ * 16; const int e2 = mm ? e : e - T_ * 16; const int t = mm ? (e2 >> 4) : (e2 >> 3), i = mm ? (e2 & 15) : (e2 & 7);
                const double ang = (double)positions[t] * (double)(mm ? INV_M[i] : INV_T[i]); const double kk = __builtin_rint(ang * 0.15915494309189535);
                const float r = (float)(ang - kk * 6.283185307179586);
                if (mm) { COSM[e2] = cosf(r); SINM[e2] = sinf(r); } else { COST[e2] = cosf(r); SINT[e2] = sinf(r); } }
            for (int e = gt; e < 2048; e += NGT) { const int g = e >> 6; const float dt = expf(s5_logdt[g]), lr = s5_lre[e], li = s5_lim[e];
                const float mag = expf(lr * dt), ang = li * dt, are = mag * cosf(ang), aim = mag * sinf(ang);
                const float den = lr * lr + li * li, nr = are - 1.f, fre = (nr * lr + aim * li) / den, fim = (aim * lr - nr * li) / den;
                AB[e] = (f32x2){are, aim};
                const float mag64 = expf(lr * dt * 64.f), ang64 = ang * 64.f; ABL[e] = (f32x2){mag64 * cosf(ang64), mag64 * sinf(ang64)};
                for (int h = 0; h < 16; ++h) { const float br = s5_bre[e * 16 + h], bi = s5_bim[e * 16 + h]; BB[e * 16 + h] = (f32x2){fre * br - fim * bi, fre * bi + fim * br}; } }
        } } else if (EN(1) && ffn_a) {
            const int idx = (ph == 1) ? 0 : (ph == 8) ? 1 : (ph == 10) ? 2 : 3; const int si = (ph == 1) ? 0 : (ph == 8) ? 2 : (ph == 10) ? 3 : 5;
            pg8::Gemm g{XB, WGU + (size_t)idx * 2 * FF_ * D_, T_, 2 * FF_, D_, D_, D_}; pg8::StaticOrder S; S.init(T_, 2 * FF_, G, bx);
            EpiSwiglu E{ACT, SS + si * T_};
            for (int rep_ = 0; rep_ < REP_FFNA; ++rep_) { pg8::gemm_phase<EpiSwiglu, pg8::StaticOrder, true, true>(lds, g, S, E); __syncthreads(); }
        } else if (EN(2) && ffn_b) {
            const int idx = (ph == 2) ? 0 : (ph == 9) ? 1 : (ph == 11) ? 2 : 3; const int so = (ph == 2) ? 1 : (ph == 9) ? 3 : (ph == 11) ? 4 : -1;
            pg8::Gemm g{ACT, WD + (size_t)idx * D_ * FF_, T_, D_, FF_, FF_, FF_}; pg8::StaticOrder S; S.init(T_, D_, G, bx);
            EpiResid E{ph == 2 ? x_in : OUT, OUT, so >= 0 ? XB : nullptr, so >= 0 ? SS + so * T_ : nullptr, 0.5f};
            pg8::gemm_phase<EpiResid, pg8::StaticOrder, true, true>(lds, g, S, E);
        } else if (EN(7) && (ph == 7 || ph == 14)) {
            pg8::Gemm g{ph == 7 ? MIX : OA, ph == 7 ? WEVOUT : WODOUT, T_, D_, D_, D_, D_}; pg8::StaticOrder S; S.init(T_, D_, G, bx);
            EpiResid E{OUT, OUT, XB, SS + (ph == 7 ? 2 : 5) * T_, 1.0f};
            pg8::gemm_phase<EpiResid, pg8::StaticOrder, true, true>(lds, g, S, E);
        } else if (EN(3) && ph == 3) {
            pg8::Gemm g{XB, WEVIN, T_, 1280, D_, D_, D_}; pg8::StaticOrder S; S.init(T_, 1280, G, bx);
            EpiEvIn E{SS + 1 * T_, U, CQ, CKV, KPE, SS + 6 * T_, SS + 7 * T_, COSM, SINM};
            pg8::gemm_phase<EpiEvIn, pg8::StaticOrder, true, true>(lds, g, S, E);
        } else if (EN(4) && ph == 4) {
            if (EN(18)) { pg8::Gemm g{CQ, WUQ, T_, 768, 384, 384, 384}; pg8::StaticOrder S; S.init(T_, 768, G, bx);
              EpiQ E{SS + 6 * T_, Q1, COSM, SINM};
              pg8::gemm_phase<EpiQ, pg8::StaticOrder, true, true>(lds, g, S, E); }
            __syncthreads();
            if (EN(19)) { pg8::Gemm g{CKV, WUKV, T_, 1024, 256, 256, 256}; pg8::StaticOrder S; S.init(T_, 1024, G, bx);
              EpiKV E{SS + 7 * T_, K1, VT1, KPE};
              pg8::gemm_phase<EpiKV, pg8::StaticOrder, true, true>(lds, g, S, E); }
            __syncthreads();
            if (EN(20)) for (int rep_ = 0; rep_ < REP_S5A; ++rep_) { TIDVARS; s5_pass<false>(lds, U, AB, ABL, BB, ST, s5_cre, s5_cim, s5_d, GB, gw, NGW, w, lane); }
        } else if (EN(5) && ph == 5) {
            for (int rep_ = 0; rep_ < REP_MLA; ++rep_) for (int i = vcu; i < 256; i += G) { const int bh = i >> 4, s = i & 15;
#pragma unroll 1
                for (int k = 0; k < 2; ++k) { const int qb = k ? s : 31 - s; f32x16 o[2];
                    attn_unit<96, 64>(Q1 + (size_t)bh * S_ * 96, K1 + (size_t)bh * S_ * 96, VT1 + (size_t)bh * 64 * S_, qb, lds, o);
                    TIDVARS; const int q = lane & 31, hi = lane >> 5; const int row = (bh >> 3) * S_ + qb * 256 + w * 32 + q;
                    bf16_t* op = MIX + (size_t)row * D_ + 512 + (bh & 7) * 64;
#pragma unroll
                    for (int blk = 0; blk < 2; ++blk)
#pragma unroll
                        for (int r4 = 0; r4 < 4; ++r4) { u32x2 v = {pk2(o[blk][4 * r4], o[blk][4 * r4 + 1]), pk2(o[blk][4 * r4 + 2], o[blk][4 * r4 + 3])}; *(u32x2*)(op + 32 * blk + 8 * r4 + 4 * hi) = v; } } }
            __syncthreads();
            for (int rep_ = 0; rep_ < REP_S5C; ++rep_) { TIDVARS; s5_pass<true>(lds, U, AB, ABL, BB, ST, s5_cre, s5_cim, s5_d, GB, gw, NGW, w, lane); }
        } else if (EN(6) && ph == 6) {
            pg8::Gemm g{GB, WGLU, T_, 512, 512, 512, 512}; pg8::StaticOrder S; S.init(T_, 512, G, bx);
            EpiGlu E{GB, s5_bglu, MIX};
            pg8::gemm_phase<EpiGlu, pg8::StaticOrder, true, true>(lds, g, S, E);
        } else if (EN(12) && ph == 12) {
            pg8::Gemm g{XB, WODIN, T_, 3072, D_, D_, D_}; pg8::StaticOrder S; S.init(T_, 3072, G, bx);
            EpiOdIn E{SS + 4 * T_, Q2, K2, VT2, COST, SINT};
            pg8::gemm_phase<EpiOdIn, pg8::StaticOrder, true, true>(lds, g, S, E);
        } else if (EN(13) && ph == 13) {
            float lam;
            { TIDVARS; const float pa = lq1[lane] * lk1[lane], pb = lq2[lane] * lk2[lane]; lam = expf(wave_sum(pa)) - expf(wave_sum(pb)) + LAM_INIT; }
            for (int rep_ = 0; rep_ < REP_DIFF; ++rep_) for (int i = vcu; i < 256; i += G) { const int bh = i >> 4, s = i & 15;
#pragma unroll 1
                for (int k = 0; k < 2; ++k) { const int qb = k ? s : 31 - s; f32x16 o[4];
#define O1S_PTR(tidv) ((f32x4*)(ws + WS_O1S) + (size_t)(bx * 8 + ((tidv) >> 6)) * 16 * 64 + ((tidv) & 63))
#pragma unroll 1
                    for (int mi = 0; mi < 2; ++mi) {
                        attn_unit<64, 128>(Q2 + (size_t)(bh * 2 + mi) * S_ * 64, K2 + (size_t)(bh * 2 + mi) * S_ * 64, VT2 + (size_t)bh * 128 * S_, qb, lds, o);
                        if (mi == 0) { f32x4* o1s = O1S_PTR(opaque_tid());
#pragma unroll
                            for (int blk = 0; blk < 4; ++blk)
#pragma unroll
                                for (int r4 = 0; r4 < 4; ++r4) o1s[(blk * 4 + r4) * 64] = (f32x4){o[blk][4 * r4], o[blk][4 * r4 + 1], o[blk][4 * r4 + 2], o[blk][4 * r4 + 3]}; } }
                    TIDVARS; const f32x4* o1s = O1S_PTR(tid);
                    float sq = 0.f;
#pragma unroll
                    for (int blk = 0; blk < 4; ++blk)
#pragma unroll
                        for (int r4 = 0; r4 < 4; ++r4) { const f32x4 o1v = o1s[(blk * 4 + r4) * 64];
#pragma unroll
                            for (int i = 0; i < 4; ++i) { const float v = o1v[i] - lam * o[blk][4 * r4 + i]; o[blk][4 * r4 + i] = v; sq += v * v; } }
                    sq += __shfl_xor(sq, 32);
                    const float rs = __builtin_amdgcn_rsqf(sq * (1.f / 128.f) + EPS) * (1.f - LAM_INIT);
                    const int q = lane & 31, hi = lane >> 5; const int row = (bh >> 3) * S_ + qb * 256 + w * 32 + q;
                    bf16_t* op = OA + (size_t)row * D_ + (bh & 7) * 128;
#pragma unroll
                    for (int blk = 0; blk < 4; ++blk)
#pragma unroll
                        for (int r4 = 0; r4 < 4; ++r4) { const int d = 32 * blk + 8 * r4 + 4 * hi; const f32x4 gn = *(const f32x4*)(subln + d);
                            u32x2 v = {pk2(o[blk][4 * r4] * rs * gn[0], o[blk][4 * r4 + 1] * rs * gn[1]), pk2(o[blk][4 * r4 + 2] * rs * gn[2], o[blk][4 * r4 + 3] * rs * gn[3])};
                            *(u32x2*)(op + d) = v; } } }
        } else if (EN(17) && ph == 17) { TIDVARS;
            for (int m = gw; m < T_; m += NGW) { f32x4* xr = (f32x4*)(OUT + (size_t)m * D_) + lane; f32x4 v[4]; float s = 0.f;
#pragma unroll
                for (int j = 0; j < 4; ++j) { v[j] = xr[64 * j]; s += (v[j][0] * v[j][0] + v[j][1] * v[j][1]) + (v[j][2] * v[j][2] + v[j][3] * v[j][3]); }
                const float rs = __builtin_amdgcn_rsqf(wave_sum(s) * (1.f / D_) + EPS);
#pragma unroll
                for (int j = 0; j < 4; ++j) { const f32x4 gn = *((const f32x4*)final_norm + 64 * j + lane); xr[64 * j] = v[j] * rs * gn; } }
        }
        if (ph + 1 < a.ph_hi) for (int rs_ = 0; rs_ < REP_SYNC; ++rs_) { if (a.ph_hi > N_PHASES) cg::this_grid().sync(); else xcd_barrier(xbar); }
    }
}

extern "C" void kernel_launch(void* const* d_in, const int* in_sizes, int n_in, void* d_out, int out_size, void* d_ws, size_t ws_size, hipStream_t stream) {
    static int grid = 0;
    if (grid == 0) {
        if (n_in != 31 || out_size != T_ * D_ || ws_size < WS_END) { fprintf(stderr, "kernel_launch: unexpected problem (n_in %d, out %d, ws %zu)\n", n_in, out_size, ws_size); grid = -1; return; }
        int dev = 0, cus = 0, per_cu = 0;
        hipGetDevice(&dev); hipDeviceGetAttribute(&cus, hipDeviceAttributeMultiprocessorCount, dev);
        hipFuncSetAttribute((const void*)mega_fwd, hipFuncAttributeMaxDynamicSharedMemorySize, LDS_BYTES);
        hipOccupancyMaxActiveBlocksPerMultiprocessor(&per_cu, (const void*)mega_fwd, 512, LDS_BYTES);
        if (per_cu < 1) { fprintf(stderr, "kernel_launch: occupancy query says %d blocks per CU\n", per_cu); per_cu = 1; }
        if (per_cu > 1) per_cu = 1;
        grid = cus * per_cu;
        (void)hipGetLastError();
    }
    if (grid < 0) return;
    if (hipMemsetAsync((char*)d_ws + WS_BAR, 0, BAR_ZERO_BYTES, stream) != hipSuccess) { fprintf(stderr, "kernel_launch: hipMemsetAsync of the barrier words failed\n"); return; }
    Args a{};
    for (int i = 0; i < 31; ++i) a.in[i] = d_in[i];
    a.out = (float*)d_out; a.ws = (unsigned char*)d_ws; a.ph_lo = 0; a.ph_hi = N_PHASES;
    void* kargs[] = {&a};
    hipError_t e = hipLaunchCooperativeKernel((const void*)mega_fwd, dim3(grid), dim3(512), kargs, LDS_BYTES, stream);
    if (e != hipSuccess) fprintf(stderr, "kernel_launch: cooperative launch failed: %s (grid %d)\n", hipGetErrorString(e), grid);
}
```

```cpp
#include <hip/hip_runtime.h>
#include <hip/hip_cooperative_groups.h>
#include <cstdio>
#include <cstdint>
namespace cg = cooperative_groups;
__device__ __forceinline__ int opaque_tid() { int t = threadIdx.x; asm volatile("" : "+v"(t)); return t; }
namespace pg8 {
#define PG8_LAS __attribute__((address_space(3)))
typedef unsigned short bf16_t;
typedef short bf16x8 __attribute__((ext_vector_type(8)));
typedef float f32x4 __attribute__((ext_vector_type(4)));
typedef unsigned u32x4 __attribute__((ext_vector_type(4)));
constexpr int BM = 256, BK = 64, HALF = 128, HTB = HALF * BK * 2  , STAGE_BYTES = 8 * HTB, NXCD = 8, WGM = 8;

__host__ __device__ __forceinline__ int lds_byte(int r, int c) { const int st = (r >> 4) * 2 + (c >> 5), rr = r & 15, cc = c & 31, ob = rr * 64 + cc * 2; return st * 1024 + (ob ^ (((ob >> 9) & 1) << 5)); }
__host__ __device__ __forceinline__ void stage_rc(int b, int& R, int& C) { const int st = b / 1024, sb = b % 1024, swz = sb ^ (((sb >> 9) & 1) << 5); R = (st >> 1) * 16 + swz / 64; C = (st & 1) * 32 + (swz % 64) / 2; }
__host__ __device__ __forceinline__ int perm32(int rho) { const int n = rho >> 4, i = rho & 15; return 8 * (i >> 2) + 4 * n + (i & 3); }

struct Unit { int pm, pn; };
struct Gemm { const bf16_t* A; const bf16_t* Bt; int M, N, K, lda, ldb; };

struct StaticOrder {
    int nM, nN, nwg, G, c;
    __host__ __device__ void init(int M, int N, int G_, int c_) { nM = M / BM; nN = N / BM; nwg = nM * nN; G = G_; c = c_; }
    __host__ __device__ bool next(int i, Unit& u) const {
        const long L = (long)i * G + c; if (L >= nwg) return false;
        int wgid = (int)L; { const int q = nwg / NXCD, r = nwg % NXCD, xcd = wgid % NXCD, off = wgid / NXCD; wgid = (xcd < r ? xcd * (q + 1) : r * (q + 1) + (xcd - r) * q) + off; }
        const int nig = WGM * nN, gid = wgid / nig, fm = gid * WGM, gsz = (nM - fm) < WGM ? (nM - fm) : WGM;
        u.pm = fm + ((wgid % nig) % gsz); u.pn = (wgid % nig) / gsz; return true;
    }
    __device__ __forceinline__ void a_ready(const Unit&) const {}
    __device__ __forceinline__ void done(const Unit&) const {}
};
template <class Epi, class Sched, bool ALIGN_EPI = false, bool SP2 = false>
__device__ __forceinline__ void gemm_phase(PG8_LAS unsigned char* lds, const Gemm g, const Sched& S, const Epi& E) {
    const int tid = opaque_tid(), wid = __builtin_amdgcn_readfirstlane(tid >> 6), lane = tid & 63, wr = wid >> 2, wc = wid & 3, fr = lane & 15, fq = lane >> 4;
    int nt_ = g.K / BK; asm volatile("" : "+s"(nt_)); const int nt = nt_;
    unsigned voffA[2], voffB[2];
#pragma unroll
    for (int i = 0; i < 2; ++i) { int R, C; stage_rc(tid * 16 + i * 8192, R, C); const int Rb = Epi::PERM ? ((R & ~31) + perm32(R & 31)) : R;
        voffA[i] = (unsigned)(R * g.lda + C) * 2u; voffB[i] = (unsigned)(Rb * g.ldb + C) * 2u; }
    const size_t kstep = (size_t)(BK * 2);
    const size_t hstepA = (size_t)HALF * g.lda * 2, hstepB = (size_t)HALF * g.ldb * 2;
    const size_t tstepA = 2 * hstepA, tstepB = 2 * hstepB;
    const unsigned ldsw = (unsigned)wid * 1024u;
    const int aoff = lds_byte(wr * 64 + fr, fq * 8), boff = lds_byte(wc * 32 + fr, fq * 8);
#define PG8_SA(b, h) (((b) * 2 + (h)) * HTB)
#define PG8_SB(b, h) ((4 + (b) * 2 + (h)) * HTB)
#define PG8_STAGE(bufoff, gbase, voff) do { _Pragma("unroll") for (int _i = 0; _i < 2; ++_i) \
        __builtin_amdgcn_global_load_lds((const unsigned*)((const char*)(gbase) + (voff)[_i]), (PG8_LAS unsigned*)(lds + (bufoff) + ldsw + _i * 8192), 16, 0, 0); } while (0)
#define PG8_LDA(dst, b, h) do { _Pragma("unroll") for (int m = 0; m < 4; ++m) _Pragma("unroll") for (int k = 0; k < 2; ++k) dst[m][k] = *(const PG8_LAS bf16x8*)(lds + PG8_SA(b, h) + aoff + m * 2048 + k * 1024); } while (0)
#define PG8_LDB(dst, b, h) do { _Pragma("unroll") for (int n = 0; n < 2; ++n) _Pragma("unroll") for (int k = 0; k < 2; ++k) dst[n][k] = *(const PG8_LAS bf16x8*)(lds + PG8_SB(b, h) + boff + n * 2048 + k * 1024); } while (0)
#define PG8_MMA(ai, bj, At, Bt) do { __builtin_amdgcn_s_setprio(1); _Pragma("unroll") for (int m = 0; m < 4; ++m) _Pragma("unroll") for (int n = 0; n < 2; ++n) _Pragma("unroll") for (int k = 0; k < 2; ++k) \
        acc[ai][bj][m][n] = __builtin_amdgcn_mfma_f32_16x16x32_bf16(Bt[n][k], At[m][k], acc[ai][bj][m][n], 0, 0, 0); __builtin_amdgcn_s_setprio(0); } while (0)
#define PG8_WAIT_V(n) asm volatile("s_waitcnt vmcnt(" #n ")" ::: "memory")
#define PG8_WAIT_L(n) asm volatile("s_waitcnt lgkmcnt(" #n ")" ::: "memory")
#define PG8_BAR __builtin_amdgcn_s_barrier()
#define PG8_SCHED __builtin_amdgcn_sched_barrier(0)
    Unit cur, nxt; int ui = 0;
    if (!S.next(0, cur)) return;
    f32x4 acc[2][2][4][2];
#pragma unroll
    for (int a = 0; a < 2; ++a)
#pragma unroll
        for (int b = 0; b < 2; ++b)
#pragma unroll
            for (int m = 0; m < 4; ++m)
#pragma unroll
                for (int n = 0; n < 2; ++n) acc[a][b][m][n] = (f32x4){0.f, 0.f, 0.f, 0.f};
    bf16x8 At[4][2], B0[2][2], B1[2][2];
    const char* cA = (const char*)g.A + (size_t)cur.pm * tstepA; const char* cB = (const char*)g.Bt + (size_t)cur.pn * tstepB;
    S.a_ready(cur);
    if constexpr (SP2) {
        PG8_STAGE(PG8_SB(0, 0), cB, voffB); PG8_STAGE(PG8_SB(0, 1), cB + hstepB, voffB); PG8_STAGE(PG8_SA(0, 0), cA, voffA); PG8_STAGE(PG8_SA(0, 1), cA + hstepA, voffA);
        if (wr == 1) PG8_BAR;
        PG8_WAIT_V(2); PG8_BAR;
        PG8_STAGE(PG8_SB(1, 0), cB + kstep, voffB); PG8_STAGE(PG8_SA(1, 0), cA + kstep, voffA); PG8_STAGE(PG8_SB(1, 1), cB + hstepB + kstep, voffB);
        PG8_WAIT_V(6); PG8_BAR;
    } else {
        PG8_STAGE(PG8_SB(0, 0), cB, voffB); PG8_STAGE(PG8_SA(0, 0), cA, voffA); PG8_STAGE(PG8_SB(0, 1), cB + hstepB, voffB); PG8_STAGE(PG8_SA(0, 1), cA + hstepA, voffA);
        if (wr == 1) PG8_BAR;
        PG8_WAIT_V(4); PG8_BAR;
        PG8_STAGE(PG8_SB(1, 0), cB + kstep, voffB); PG8_STAGE(PG8_SA(1, 0), cA + kstep, voffA); PG8_STAGE(PG8_SB(1, 1), cB + hstepB + kstep, voffB);
        PG8_WAIT_V(6); PG8_BAR;
    }
    for (;;) {
        const bool has_next = S.next(ui + 1, nxt);
        const char* nA = has_next ? (const char*)g.A + (size_t)nxt.pm * tstepA : cA; const char* nB = has_next ? (const char*)g.Bt + (size_t)nxt.pn * tstepB : cB;
        for (int t = 0; t < nt; t += 2) {
            const bool last = (t == nt - 2);
            const char* a1 = cA + (size_t)(t + 1) * kstep;
            const char* a2 = last ? nA : cA + (size_t)(t + 2) * kstep; const char* b2 = last ? nB : cB + (size_t)(t + 2) * kstep;
            const char* a3 = a2 + kstep; const char* b3 = b2 + kstep;
            if (last && has_next) S.a_ready(nxt);
            if constexpr (SP2) {
            PG8_LDB(B0, 0, 0); PG8_LDB(B1, 0, 1); PG8_SCHED; PG8_LDA(At, 0, 0); PG8_STAGE(PG8_SA(1, 1), a1 + hstepA, voffA);
            PG8_WAIT_V(8); PG8_WAIT_L(0); PG8_BAR; PG8_MMA(0, 0, At, B0); PG8_MMA(0, 1, At, B1); PG8_BAR; PG8_SCHED;
            PG8_LDA(At, 0, 1); PG8_STAGE(PG8_SB(0, 0), b2, voffB); PG8_STAGE(PG8_SB(0, 1), b2 + hstepB, voffB); PG8_STAGE(PG8_SA(0, 0), a2, voffA);
            PG8_WAIT_V(8); PG8_WAIT_L(0); PG8_BAR; PG8_MMA(1, 0, At, B0); PG8_MMA(1, 1, At, B1); PG8_BAR; PG8_SCHED;
            PG8_LDB(B0, 1, 0); PG8_LDB(B1, 1, 1); PG8_SCHED; PG8_LDA(At, 1, 0); PG8_STAGE(PG8_SA(0, 1), a2 + hstepA, voffA);
            PG8_WAIT_V(8); PG8_WAIT_L(0); PG8_BAR; PG8_MMA(0, 0, At, B0); PG8_MMA(0, 1, At, B1); PG8_BAR; PG8_SCHED;
            PG8_LDA(At, 1, 1); PG8_STAGE(PG8_SB(1, 0), b3, voffB); PG8_STAGE(PG8_SB(1, 1), b3 + hstepB, voffB); PG8_STAGE(PG8_SA(1, 0), a3, voffA);
            PG8_WAIT_V(8); PG8_WAIT_L(0); PG8_BAR; PG8_MMA(1, 0, At, B0); PG8_MMA(1, 1, At, B1); PG8_BAR; PG8_SCHED;
            } else {
            PG8_LDB(B0, 0, 0); PG8_SCHED; PG8_LDA(At, 0, 0); PG8_STAGE(PG8_SA(1, 1), a1 + hstepA, voffA);
            PG8_WAIT_L(8); PG8_BAR; PG8_WAIT_L(0); PG8_MMA(0, 0, At, B0); PG8_BAR; PG8_SCHED;
            PG8_LDB(B1, 0, 1); PG8_STAGE(PG8_SB(0, 0), b2, voffB);
            PG8_BAR; PG8_WAIT_L(0); PG8_MMA(0, 1, At, B1); PG8_BAR;
            PG8_LDA(At, 0, 1); PG8_STAGE(PG8_SA(0, 0), a2, voffA);
            PG8_BAR; PG8_WAIT_L(0); PG8_MMA(1, 0, At, B0); PG8_BAR; PG8_SCHED;
            PG8_STAGE(PG8_SB(0, 1), b2 + hstepB, voffB);
            PG8_WAIT_V(6); PG8_BAR; PG8_MMA(1, 1, At, B1); PG8_BAR;
            PG8_LDB(B0, 1, 0); PG8_SCHED; PG8_LDA(At, 1, 0); PG8_STAGE(PG8_SA(0, 1), a2 + hstepA, voffA);
            PG8_WAIT_L(8); PG8_BAR; PG8_WAIT_L(0); PG8_MMA(0, 0, At, B0); PG8_BAR; PG8_SCHED;
            PG8_LDB(B1, 1, 1); PG8_STAGE(PG8_SB(1, 0), b3, voffB);
            PG8_BAR; PG8_WAIT_L(0); PG8_MMA(0, 1, At, B1); PG8_BAR;
            PG8_LDA(At, 1, 1); PG8_STAGE(PG8_SA(1, 0), a3, voffA);
            PG8_BAR; PG8_WAIT_L(0); PG8_MMA(1, 0, At, B0); PG8_BAR; PG8_SCHED;
            PG8_STAGE(PG8_SB(1, 1), b3 + hstepB, voffB);
            PG8_WAIT_V(6); PG8_BAR; PG8_MMA(1, 1, At, B1); PG8_BAR;
            }
        }
        if constexpr (ALIGN_EPI) { if (wr == 0) PG8_BAR; }
        if constexpr (!Epi::AFTER_DRAIN) { E(acc, cur, wr, wc, fr, fq); S.done(cur); }
        if (!has_next) break;
#pragma unroll
        for (int a = 0; a < 2; ++a)
#pragma unroll
            for (int b = 0; b < 2; ++b)
#pragma unroll
                for (int m = 0; m < 4; ++m)
#pragma unroll
                    for (int n = 0; n < 2; ++n) acc[a][b][m][n] = (f32x4){0.f, 0.f, 0.f, 0.f};
        cur = nxt; cA = nA; cB = nB; ++ui;
        if constexpr (ALIGN_EPI) { if (wr == 1) PG8_BAR; }
    }
    PG8_WAIT_V(0);
    if constexpr (!ALIGN_EPI) { if (wr == 0) PG8_BAR; }
    PG8_BAR;
    if constexpr (Epi::AFTER_DRAIN) { E.fused(acc, cur, wr, wc, fr, fq, lds, wid, lane); S.done(cur); }
#undef PG8_SA
#undef PG8_SB
#undef PG8_STAGE
#undef PG8_LDA
#undef PG8_LDB
#undef PG8_MMA
#undef PG8_WAIT_V
#undef PG8_WAIT_L
#undef PG8_BAR
#undef PG8_SCHED
}
}
#define LAS __attribute__((address_space(3)))
typedef unsigned short bf16_t;
typedef short bf16x8 __attribute__((ext_vector_type(8)));
typedef float f32x4 __attribute__((ext_vector_type(4)));
typedef float f32x2 __attribute__((ext_vector_type(2)));
typedef float f32x16 __attribute__((ext_vector_type(16)));
typedef unsigned u32x4 __attribute__((ext_vector_type(4)));
typedef unsigned u32x2 __attribute__((ext_vector_type(2)));
typedef __bf16 bf16x2_t __attribute__((ext_vector_type(2)));
using pg8::Unit;

constexpr int T_ = 16384, S_ = 8192, D_ = 1024, FF_ = 2816;
constexpr float EPS = 1e-6f, LOG2E = 1.4426950408889634f;
constexpr float QSCALE1 = 0.10206207261596575f * LOG2E;
constexpr float QSCALE2 = 0.125f * LOG2E;
constexpr float LAM_INIT = 0.35550906759096934f;
constexpr size_t MiB = 1u << 20;
constexpr size_t WS_SS = 0, WS_S5P = 1 * MiB, WS_ROPE = 2 * MiB;
constexpr size_t WS_WGU = 6 * MiB, WS_WD = 50 * MiB, WS_WEVIN = 72 * MiB, WS_WUQ = 75 * MiB, WS_WUKV = 76 * MiB, WS_WGLU = 77 * MiB, WS_WEVOUT = 78 * MiB, WS_WODIN = 80 * MiB, WS_WODOUT = 86 * MiB;
constexpr size_t WS_XB = 88 * MiB, WS_OV = 120 * MiB;
constexpr size_t WS_ACT = WS_OV;
constexpr size_t WS_U = WS_OV, WS_CQ = WS_OV + 32 * MiB, WS_CKV = WS_OV + 44 * MiB, WS_KPE = WS_OV + 52 * MiB, WS_Q1 = WS_OV + 53 * MiB, WS_K1 = WS_OV + 77 * MiB, WS_VT1 = WS_OV + 101 * MiB,
                 WS_ST = WS_OV + 117 * MiB, WS_G = WS_OV + 121 * MiB, WS_MIX = WS_OV + 137 * MiB;
constexpr size_t WS_Q2 = WS_OV, WS_K2 = WS_OV + 32 * MiB, WS_VT2 = WS_OV + 64 * MiB, WS_OA = WS_OV + 96 * MiB, WS_O1S = WS_OV + 128 * MiB;
constexpr size_t WS_SSL = 289 * MiB;
constexpr size_t WS_END = 297 * MiB;
constexpr int LDS_BYTES = 135168;

__constant__ float INV_M[16] = {1.000000000e+00f, 5.623413252e-01f, 3.162277660e-01f, 1.778279410e-01f, 1.000000000e-01f, 5.623413252e-02f, 3.162277660e-02f, 1.778279410e-02f,
                                1.000000000e-02f, 5.623413252e-03f, 3.162277660e-03f, 1.778279410e-03f, 1.000000000e-03f, 5.623413252e-04f, 3.162277660e-04f, 1.778279410e-04f};
__constant__ float INV_T[8] = {1.000000000e+00f, 1.939227447e-01f, 3.760603093e-02f, 7.292664737e-03f, 1.414213562e-03f, 2.742481757e-04f, 5.318295897e-05f, 1.031338538e-05f};

__device__ __forceinline__ unsigned pk2(float lo, float hi) { f32x2 v = {lo, hi}; bf16x2_t b = __builtin_convertvector(v, bf16x2_t); return __builtin_bit_cast(unsigned, b); }
__device__ __forceinline__ float bf2f(unsigned h) { return __builtin_bit_cast(float, h << 16); }
__device__ __forceinline__ float wave_sum(float v) {
#pragma unroll
    for (int o = 1; o < 64; o <<= 1) v += __shfl_xor(v, o);
    return v;
}
__device__ __forceinline__ void wave_lds_sync() { asm volatile("s_waitcnt lgkmcnt(0)" ::: "memory"); __builtin_amdgcn_wave_barrier(); }
__device__ __forceinline__ float sigmoidf_(float v) { return __builtin_amdgcn_rcpf(1.f + __builtin_amdgcn_exp2f(-v * LOG2E)); }
typedef __attribute__((address_space(1))) void* gvoidp;
__device__ __forceinline__ gvoidp ldptr(const LAS unsigned long long* tab, int i) { const unsigned long long v = tab[i]; const unsigned lo = __builtin_amdgcn_readfirstlane((unsigned)v), hi = __builtin_amdgcn_readfirstlane((unsigned)(v >> 32)); return (gvoidp)(((unsigned long long)hi << 32) | lo); }
template <int N4> __device__ __forceinline__ float ss_sum(const float* slots, int row) { const f32x4* p = (const f32x4*)(slots + (size_t)row * 16); float t = 0.f;
#pragma unroll
    for (int i = 0; i < N4; ++i) { const f32x4 v = p[i]; t += (v[0] + v[1]) + (v[2] + v[3]); }
    return t; }
__device__ __forceinline__ int swap23(int s) { return (s & ~12) | ((s & 4) << 1) | ((s & 8) >> 1); }

struct EpiSwiglu { static constexpr bool PERM = true, AFTER_DRAIN = false;
    bf16_t* O; const float* ss;
    __device__ __forceinline__ void operator()(const f32x4 (&acc)[2][2][4][2], const Unit& u, int wr, int wc, int fr, int fq) const {
        const int row0 = u.pm * 256 + wr * 64 + fr, col0 = u.pn * 128 + wc * 32 + 8 * fq;
#pragma unroll
        for (int ai = 0; ai < 2; ++ai)
#pragma unroll
            for (int m = 0; m < 4; ++m) { int row = row0 + ai * 128 + m * 16; asm volatile("" : "+v"(row) :: "memory"); const float rs = __builtin_amdgcn_rsqf(ss_sum<4>(ss, row) * (1.f / D_) + EPS);
                float a[8];
#pragma unroll
                for (int n = 0; n < 2; ++n)
#pragma unroll
                    for (int i = 0; i < 4; ++i) { const float g = acc[ai][0][m][n][i] * rs, uu = acc[ai][1][m][n][i] * rs; a[4 * n + i] = g * sigmoidf_(g) * uu; }
                u32x4 w = {pk2(a[0], a[1]), pk2(a[2], a[3]), pk2(a[4], a[5]), pk2(a[6], a[7])};
                *(u32x4*)(O + (size_t)row * FF_ + col0) = w; }
    }
};
struct EpiResid { static constexpr bool PERM = true, AFTER_DRAIN = false;
    const float* Xin32; const bf16_t* XinB; float* Xout32; bf16_t* XB; float* ssout; float sc;
    __device__ __forceinline__ void operator()(const f32x4 (&acc)[2][2][4][2], const Unit& u, int wr, int wc, int fr, int fq) const {
        const int row0 = u.pm * 256 + wr * 64 + fr, col0 = u.pn * 256 + wc * 32 + 8 * fq;
#pragma unroll
        for (int ai = 0; ai < 2; ++ai)
#pragma unroll
            for (int m = 0; m < 4; ++m) { int row = row0 + ai * 128 + m * 16; asm volatile("" : "+v"(row) :: "memory"); float sq = 0.f;
#pragma unroll
                for (int bj = 0; bj < 2; ++bj) { const size_t off = (size_t)row * D_ + col0 + bj * 128;
                    f32x4 x0, x1;
                    if (Xin32) { x0 = *(const f32x4*)(Xin32 + off); x1 = *(const f32x4*)(Xin32 + off + 4); }
                    else { const u32x4 xw = *(const u32x4*)(XinB + off); x0 = (f32x4){bf2f(xw[0] & 0xffffu), bf2f(xw[0] >> 16), bf2f(xw[1] & 0xffffu), bf2f(xw[1] >> 16)};
                           x1 = (f32x4){bf2f(xw[2] & 0xffffu), bf2f(xw[2] >> 16), bf2f(xw[3] & 0xffffu), bf2f(xw[3] >> 16)}; }
                    x0 = x0 + acc[ai][bj][m][0] * sc; x1 = x1 + acc[ai][bj][m][1] * sc;
                    if (Xout32) { *(f32x4*)(Xout32 + off) = x0; *(f32x4*)(Xout32 + off + 4) = x1; }
                    if (XB) { u32x4 w = {pk2(x0[0], x0[1]), pk2(x0[2], x0[3]), pk2(x1[0], x1[1]), pk2(x1[2], x1[3])}; *(u32x4*)(XB + off) = w; }
                    sq += (x0[0] * x0[0] + x0[1] * x0[1]) + (x0[2] * x0[2] + x0[3] * x0[3]) + (x1[0] * x1[0] + x1[1] * x1[1]) + (x1[2] * x1[2] + x1[3] * x1[3]); }
                if (ssout) { sq += __shfl_xor(sq, 16); sq += __shfl_xor(sq, 32); if (fq == 0) ssout[(size_t)row * 16 + u.pn * 4 + wc] = sq; } }
    }
};
__device__ __forceinline__ void rope8(float (&v)[8], f32x4 c4, f32x4 s4) {
#pragma unroll
    for (int e = 0; e < 4; ++e) { const float x1 = v[2 * e], x2 = v[2 * e + 1]; v[2 * e] = x1 * c4[e] - x2 * s4[e]; v[2 * e + 1] = x2 * c4[e] + x1 * s4[e]; }
}
struct EpiEvIn { static constexpr bool PERM = true, AFTER_DRAIN = false;
    const float* ss; float* U; bf16_t* CQ; bf16_t* CKV; bf16_t* KPE; float* ssq; float* sskv; const float* cosm; const float* sinm;
    __device__ __forceinline__ void operator()(const f32x4 (&acc)[2][2][4][2], const Unit& u, int wr, int wc, int fr, int fq) const {
        const int row0 = u.pm * 256 + wr * 64 + fr;
#pragma unroll
        for (int ai = 0; ai < 2; ++ai)
#pragma unroll
            for (int m = 0; m < 4; ++m) { int row = row0 + ai * 128 + m * 16; asm volatile("" : "+v"(row) :: "memory"); const float rs = __builtin_amdgcn_rsqf(ss_sum<4>(ss, row) * (1.f / D_) + EPS);
                float sq = 0.f, skv = 0.f;
#pragma unroll
                for (int bj = 0; bj < 2; ++bj) { const int col = u.pn * 256 + bj * 128 + wc * 32 + 8 * fq;
                    float v[8];
#pragma unroll
                    for (int n = 0; n < 2; ++n)
#pragma unroll
                        for (int i = 0; i < 4; ++i) v[4 * n + i] = acc[ai][bj][m][n][i] * rs;
                    if (col < 512) { float* p = U + (size_t)row * 512 + col; *(f32x4*)p = (f32x4){v[0], v[1], v[2], v[3]}; *(f32x4*)(p + 4) = (f32x4){v[4], v[5], v[6], v[7]}; }
                    else if (col < 896) { u32x4 w = {pk2(v[0], v[1]), pk2(v[2], v[3]), pk2(v[4], v[5]), pk2(v[6], v[7])}; *(u32x4*)(CQ + (size_t)row * 384 + (col - 512)) = w;
#pragma unroll
                        for (int i = 0; i < 8; ++i) sq += v[i] * v[i]; }
                    else if (col < 928) { const int i0 = (col - 896) >> 1;
                        const f32x4 c4 = *(const f32x4*)(cosm + (size_t)row * 16 + i0), s4 = *(const f32x4*)(sinm + (size_t)row * 16 + i0); rope8(v, c4, s4);
                        u32x4 w = {pk2(v[0], v[1]), pk2(v[2], v[3]), pk2(v[4], v[5]), pk2(v[6], v[7])}; *(u32x4*)(KPE + (size_t)row * 32 + (col - 896)) = w; }
                    else if (col >= 1024) { u32x4 w = {pk2(v[0], v[1]), pk2(v[2], v[3]), pk2(v[4], v[5]), pk2(v[6], v[7])}; *(u32x4*)(CKV + (size_t)row * 256 + (col - 1024)) = w;
#pragma unroll
                        for (int i = 0; i < 8; ++i) skv += v[i] * v[i]; } }
                if (u.pn == 2 || u.pn == 3) { sq += __shfl_xor(sq, 16); sq += __shfl_xor(sq, 32); if (fq == 0) ssq[(size_t)row * 16 + (u.pn - 2) * 4 + wc] = sq; }
                if (u.pn == 4) { skv += __shfl_xor(skv, 16); skv += __shfl_xor(skv, 32); if (fq == 0) sskv[(size_t)row * 16 + wc] = skv; } }
    }
};
struct EpiQ { static constexpr bool PERM = true, AFTER_DRAIN = false;
    const float* ssq; bf16_t* Q1; const float* cosm; const float* sinm;
    __device__ __forceinline__ void operator()(const f32x4 (&acc)[2][2][4][2], const Unit& u, int wr, int wc, int fr, int fq) const {
        const int row0 = u.pm * 256 + wr * 64 + fr;
#pragma unroll
        for (int ai = 0; ai < 2; ++ai)
#pragma unroll
            for (int m = 0; m < 4; ++m) { int row = row0 + ai * 128 + m * 16; asm volatile("" : "+v"(row) :: "memory"); const float rs = __builtin_amdgcn_rsqf(ss_sum<2>(ssq, row) * (1.f / 384.f) + EPS) * QSCALE1;
                const int b = row >> 13, s = row & (S_ - 1);
#pragma unroll
                for (int bj = 0; bj < 2; ++bj) { const int col = u.pn * 256 + bj * 128 + wc * 32 + 8 * fq, h = col / 96, j = col - h * 96;
                    float v[8];
#pragma unroll
                    for (int n = 0; n < 2; ++n)
#pragma unroll
                        for (int i = 0; i < 4; ++i) v[4 * n + i] = acc[ai][bj][m][n][i] * rs;
                    if (j >= 64) { const int i0 = (j - 64) >> 1; const f32x4 c4 = *(const f32x4*)(cosm + (size_t)row * 16 + i0), s4 = *(const f32x4*)(sinm + (size_t)row * 16 + i0); rope8(v, c4, s4); }
                    u32x4 w = {pk2(v[0], v[1]), pk2(v[2], v[3]), pk2(v[4], v[5]), pk2(v[6], v[7])};
                    *(u32x4*)(Q1 + ((size_t)(b * 8 + h) * S_ + s) * 96 + j) = w; } }
    }
};
struct EpiKV { static constexpr bool PERM = true, AFTER_DRAIN = false;
    const float* sskv; bf16_t* K1; bf16_t* VT1; const bf16_t* KPE;
    __device__ __forceinline__ void operator()(const f32x4 (&acc)[2][2][4][2], const Unit& u, int wr, int wc, int fr, int fq) const {
        const int row0 = u.pm * 256 + wr * 64 + fr;
#pragma unroll
        for (int ai = 0; ai < 2; ++ai)
#pragma unroll
            for (int m = 0; m < 4; ++m) { int row = row0 + ai * 128 + m * 16; asm volatile("" : "+v"(row) :: "memory"); const float rs = __builtin_amdgcn_rsqf(ss_sum<1>(sskv, row) * (1.f / 256.f) + EPS);
                const int b = row >> 13, s = row & (S_ - 1);
#pragma unroll
                for (int bj = 0; bj < 2; ++bj) { const int col = u.pn * 256 + bj * 128 + wc * 32 + 8 * fq, h = col >> 7, j = col & 127;
                    float v[8];
#pragma unroll
                    for (int n = 0; n < 2; ++n)
#pragma unroll
                        for (int i = 0; i < 4; ++i) v[4 * n + i] = acc[ai][bj][m][n][i] * rs;
                    if (j < 64) { bf16_t* kp = K1 + ((size_t)(b * 8 + h) * S_ + s) * 96;
                        u32x4 w = {pk2(v[0], v[1]), pk2(v[2], v[3]), pk2(v[4], v[5]), pk2(v[6], v[7])}; *(u32x4*)(kp + j) = w;
                        if (j < 32) *(u32x4*)(kp + 64 + j) = *(const u32x4*)(KPE + (size_t)row * 32 + j); }
                    else { bf16_t* vp = VT1 + (((size_t)(b * 8 + h) * (S_ / 64) + (s >> 6)) * 64 + (j - 64)) * 64 + swap23(s & 63);
#pragma unroll
                        for (int i = 0; i < 8; i += 2) { const unsigned w = pk2(v[i], v[i + 1]); vp[i * 64] = (bf16_t)(w & 0xffffu); vp[(i + 1) * 64] = (bf16_t)(w >> 16); } } } }
    }
};
struct EpiGlu { static constexpr bool PERM = true, AFTER_DRAIN = false;
    const bf16_t* G; const float* bias; bf16_t* MIX;
    __device__ __forceinline__ void operator()(const f32x4 (&acc)[2][2][4][2], const Unit& u, int wr, int wc, int fr, int fq) const {
        const int row0 = u.pm * 256 + wr * 64 + fr;
#pragma unroll
        for (int bj = 0; bj < 2; ++bj) { const int col = u.pn * 256 + bj * 128 + wc * 32 + 8 * fq;
            const f32x4 b0 = *(const f32x4*)(bias + col), b1 = *(const f32x4*)(bias + col + 4);
#pragma unroll
            for (int ai = 0; ai < 2; ++ai)
#pragma unroll
                for (int m = 0; m < 4; ++m) { int row = row0 + ai * 128 + m * 16; asm volatile("" : "+v"(row) :: "memory");
                    const u32x4 gw = *(const u32x4*)(G + (size_t)row * 512 + col);
                    const f32x4 z0 = acc[ai][bj][m][0] + b0, z1 = acc[ai][bj][m][1] + b1; float o[8];
#pragma unroll
                    for (int i = 0; i < 4; ++i) { const unsigned ww = gw[i]; o[2 * i] = bf2f(ww & 0xffffu); o[2 * i + 1] = bf2f(ww >> 16); }
#pragma unroll
                    for (int i = 0; i < 4; ++i) { o[i] *= sigmoidf_(z0[i]); o[4 + i] *= sigmoidf_(z1[i]); }
                    u32x4 w = {pk2(o[0], o[1]), pk2(o[2], o[3]), pk2(o[4], o[5]), pk2(o[6], o[7])};
                    *(u32x4*)(MIX + (size_t)row * D_ + col) = w; } }
    }
};
struct EpiOdIn { static constexpr bool PERM = true, AFTER_DRAIN = false;
    const float* ss; bf16_t* Q2; bf16_t* K2; bf16_t* VT2; const float* cost; const float* sint;
    __device__ __forceinline__ void operator()(const f32x4 (&acc)[2][2][4][2], const Unit& u, int wr, int wc, int fr, int fq) const {
        const int row0 = u.pm * 256 + wr * 64 + fr; const int sec = u.pn >> 2;
#pragma unroll
        for (int ai = 0; ai < 2; ++ai)
#pragma unroll
            for (int m = 0; m < 4; ++m) { int row = row0 + ai * 128 + m * 16; asm volatile("" : "+v"(row) :: "memory"); float rs = __builtin_amdgcn_rsqf(ss_sum<4>(ss, row) * (1.f / D_) + EPS); if (sec == 0) rs *= QSCALE2;
                const int b = row >> 13, s = row & (S_ - 1);
#pragma unroll
                for (int bj = 0; bj < 2; ++bj) { const int cc = (u.pn & 3) * 256 + bj * 128 + wc * 32 + 8 * fq, h = cc >> 7, wi = cc & 127;
                    float v[8];
#pragma unroll
                    for (int n = 0; n < 2; ++n)
#pragma unroll
                        for (int i = 0; i < 4; ++i) v[4 * n + i] = acc[ai][bj][m][n][i] * rs;
                    if (sec < 2) { const int mi = wi >> 6, d = wi & 63;
                        if (d < 16) { const int i0 = d >> 1; const f32x4 c4 = *(const f32x4*)(cost + (size_t)row * 8 + i0), s4 = *(const f32x4*)(sint + (size_t)row * 8 + i0); rope8(v, c4, s4); }
                        u32x4 w = {pk2(v[0], v[1]), pk2(v[2], v[3]), pk2(v[4], v[5]), pk2(v[6], v[7])};
                        bf16_t* base = sec == 0 ? Q2 : K2; *(u32x4*)(base + ((size_t)((b * 8 + h) * 2 + mi) * S_ + s) * 64 + d) = w; }
                    else { bf16_t* vp = VT2 + (((size_t)(b * 8 + h) * (S_ / 64) + (s >> 6)) * 128 + wi) * 64 + swap23(s & 63);
#pragma unroll
                        for (int i = 0; i < 8; i += 2) { const unsigned w = pk2(v[i], v[i + 1]); vp[i * 64] = (bf16_t)(w & 0xffffu); vp[(i + 1) * 64] = (bf16_t)(w >> 16); } } } }
    }
};
__device__ __forceinline__ int perm_src(int n, int mode) {
    if (mode == 1) return (n >> 1) + ((n & 1) << 4);
    if (mode == 2) return n < 16 ? ((n >> 1) + ((n & 1) << 3)) : n;
    return n;
}
__device__ __forceinline__ void tr_item(const float* __restrict__ W, int K, int Ns, int n0s, int pmode, const float* __restrict__ gain, bf16_t* __restrict__ WT, int n0d, int k0, LAS float* scr, int lane) {
    const int c = lane & 7;
    if (n0s < 0) {
#pragma unroll
        for (int j = 0; j < 4; ++j) { const int n = (lane >> 3) + 8 * j; *(u32x4*)(WT + (size_t)(n0d + n) * K + k0 + 8 * c) = (u32x4){0u, 0u, 0u, 0u}; }
        return; }
    float wv[32];
#pragma unroll
    for (int i = 0; i < 32; ++i) wv[i] = W[(size_t)(k0 + 2 * i + (lane >> 5)) * Ns + n0s + (lane & 31)];
#pragma unroll
    for (int i = 0; i < 32; ++i) { const int kk = 2 * i + (lane >> 5); float v = wv[i]; if (gain) v *= gain[k0 + kk]; scr[kk * 33 + (lane & 31)] = v; }
    wave_lds_sync();
#pragma unroll
    for (int j = 0; j < 4; ++j) { const int n = (lane >> 3) + 8 * j; const LAS float* s = scr + (8 * c) * 33 + perm_src(n, pmode);
        u32x4 o; o.x = pk2(s[0 * 33], s[1 * 33]); o.y = pk2(s[2 * 33], s[3 * 33]); o.z = pk2(s[4 * 33], s[5 * 33]); o.w = pk2(s[6 * 33], s[7 * 33]);
        *(u32x4*)(WT + (size_t)(n0d + n) * K + k0 + 8 * c) = o; }
    wave_lds_sync();
}
__device__ __forceinline__ void map_block(int mode, int n0d, int& n0s, int& pm) {
    pm = 0; n0s = n0d;
    if (mode == 1) { const int tile = n0d >> 8, w = n0d & 255; n0s = (w < 128) ? (tile * 128 + w) : (FF_ + tile * 128 + (w - 128)); }
    else if (mode == 2) { if (n0d < 896) n0s = n0d; else if (n0d == 896) { n0s = 1152; pm = 1; } else if (n0d < 1024) n0s = -1; else n0s = n0d - 1024 + 896; }
    else if (mode == 3) { if (((n0d >> 5) % 3) == 2) pm = 1; }
    else if (mode == 4) { if (n0d < 2048 && (n0d & 63) == 0) pm = 2; }
}

struct Args { const void* in[31]; float* out; unsigned char* ws; int ph_lo, ph_hi; };

template <int DK>
__device__ __forceinline__ void attn_qk(f32x16& p0, f32x16& p1, const LAS unsigned char* kb, const bf16x8 (&qf)[DK / 16], int q, int hi) {
    constexpr int KP = DK * 2 + 16;
#pragma unroll
    for (int r = 0; r < 16; ++r) { p0[r] = 0.f; p1[r] = 0.f; }
#pragma unroll
    for (int ks = 0; ks < DK / 16; ++ks) {
        const bf16x8 k0 = *(const LAS bf16x8*)(kb + q * KP + ks * 32 + hi * 16);
        const bf16x8 k1 = *(const LAS bf16x8*)(kb + (32 + q) * KP + ks * 32 + hi * 16);
        p0 = __builtin_amdgcn_mfma_f32_32x32x16_bf16(k0, qf[ks], p0, 0, 0, 0);
        p1 = __builtin_amdgcn_mfma_f32_32x32x16_bf16(k1, qf[ks], p1, 0, 0, 0);
    }
}
template <int DV>
__device__ __forceinline__ void attn_prep(f32x16& p0, f32x16& p1, f32x16 (&o)[DV / 32], float& mhat, float& lrun, f32x16& negm, bool first, int jb, int w, int q, int hi) {
    if (jb >= 0) { const int kvb = 64 * jb + 4 * hi, qrel = 32 * w + q;
#pragma unroll
        for (int r = 0; r < 16; ++r) { const int kv = kvb + (r & 3) + 8 * (r >> 2); if (kv > qrel) p0[r] = -INFINITY; if (kv + 32 > qrel) p1[r] = -INFINITY; } }
    float tm = fmaxf(p0[0], p1[0]);
#pragma unroll
    for (int r = 1; r < 16; ++r) tm = fmaxf(tm, fmaxf(p0[r], p1[r]));
    { auto rr = __builtin_amdgcn_permlane32_swap(__float_as_uint(tm), __float_as_uint(tm), false, false); tm = fmaxf(__uint_as_float(rr[0]), __uint_as_float(rr[1])); }
    if (first || __any(tm > 6.f)) { const float delta = first ? tm : fmaxf(tm, 0.f), alpha = first ? 1.f : __builtin_amdgcn_exp2f(-delta); mhat += delta; lrun *= alpha;
#pragma unroll
        for (int r = 0; r < 16; ++r) { p0[r] -= delta; p1[r] -= delta; negm[r] = -mhat; }
#pragma unroll
        for (int blk = 0; blk < DV / 32; ++blk)
#pragma unroll
            for (int r = 0; r < 16; ++r) o[blk][r] *= alpha; }
}
template <int DV>
__device__ __forceinline__ void attn_exp_pv(const f32x16& p0, const f32x16& p1, f32x16 (&o)[DV / 32], float mhat, float& lrun, const LAS unsigned char* vb, int q, int hi) {
    constexpr int VP = 144;
    float ls = 0.f;
#pragma unroll
    for (int j = 0; j < 4; ++j) { float e[8];
#pragma unroll
        for (int i = 0; i < 8; ++i) { const float sv = (j < 2) ? p0[8 * (j & 1) + i] : p1[8 * (j & 1) + i]; e[i] = __builtin_amdgcn_exp2f(sv - mhat); }
        ls += ((e[0] + e[1]) + (e[2] + e[3])) + ((e[4] + e[5]) + (e[6] + e[7]));
        u32x4 pa = {pk2(e[0], e[1]), pk2(e[2], e[3]), pk2(e[4], e[5]), pk2(e[6], e[7])}; const bf16x8 pw = __builtin_bit_cast(bf16x8, pa);
#pragma unroll
        for (int blk = 0; blk < DV / 32; ++blk) { const bf16x8 a = *(const LAS bf16x8*)(vb + (32 * blk + q) * VP + (16 * j + 8 * hi) * 2);
            o[blk] = __builtin_amdgcn_mfma_f32_32x32x16_bf16(a, pw, o[blk], 0, 0, 0); } }
    lrun += ls;
}
template <int DK, int DV>
__device__ __forceinline__ void attn_fused(f32x16& n0, f32x16& n1, const f32x16& p0, const f32x16& p1, f32x16 (&o)[DV / 32], float mhat, float& lrun, const LAS unsigned char* kb, const LAS unsigned char* vb,
                                           const bf16x8 (&qf)[DK / 16], const f32x16& negm, int q, int hi) {
    constexpr int KP = DK * 2 + 16, VP = 144, NKS = DK / 16;
    n0 = negm; n1 = negm;
    float ls = 0.f;
#pragma unroll
    for (int j = 0; j < 4; ++j) {
#pragma unroll
        for (int ks = (j * NKS) / 4; ks < ((j + 1) * NKS) / 4; ++ks) {
            const bf16x8 k0 = *(const LAS bf16x8*)(kb + q * KP + ks * 32 + hi * 16);
            const bf16x8 k1 = *(const LAS bf16x8*)(kb + (32 + q) * KP + ks * 32 + hi * 16);
            n0 = __builtin_amdgcn_mfma_f32_32x32x16_bf16(k0, qf[ks], n0, 0, 0, 0);
            n1 = __builtin_amdgcn_mfma_f32_32x32x16_bf16(k1, qf[ks], n1, 0, 0, 0); }
        float e[8];
#pragma unroll
        for (int i = 0; i < 8; ++i) { const float sv = (j < 2) ? p0[8 * (j & 1) + i] : p1[8 * (j & 1) + i]; e[i] = __builtin_amdgcn_exp2f(sv); }
        ls += ((e[0] + e[1]) + (e[2] + e[3])) + ((e[4] + e[5]) + (e[6] + e[7]));
        u32x4 pa = {pk2(e[0], e[1]), pk2(e[2], e[3]), pk2(e[4], e[5]), pk2(e[6], e[7])}; const bf16x8 pw = __builtin_bit_cast(bf16x8, pa);
#pragma unroll
        for (int blk = 0; blk < DV / 32; ++blk) { const bf16x8 a = *(const LAS bf16x8*)(vb + (32 * blk + q) * VP + (16 * j + 8 * hi) * 2);
            o[blk] = __builtin_amdgcn_mfma_f32_32x32x16_bf16(a, pw, o[blk], 0, 0, 0); }
        __builtin_amdgcn_sched_barrier(0);
    }
    lrun += ls;
}
template <int DK, int DV>
__device__ __forceinline__ void attn_unit(const bf16_t* __restrict__ Qh, const bf16_t* __restrict__ Kh, const bf16_t* __restrict__ Vth, int qb, LAS unsigned char* lds, f32x16 (&o)[DV / 32]) {
    constexpr int KP = DK * 2 + 16, VP = 144, KBYTES = 64 * KP, VBYTES = DV * VP, VOFF = 2 * KBYTES;
    constexpr int KC = DK / 8, KCH = 64 * KC, KN = (KCH + 511) / 512, VN = DV * 8 / 512;
    const int tid = opaque_tid(), lane = tid & 63, w = __builtin_amdgcn_readfirstlane(tid >> 6), q = lane & 31, hi = lane >> 5;
    bf16x8 qf[DK / 16];
    { const bf16_t* qp = Qh + (size_t)(qb * 256 + w * 32 + q) * DK + hi * 8;
#pragma unroll
      for (int ks = 0; ks < DK / 16; ++ks) qf[ks] = *(const bf16x8*)(qp + ks * 16); }
#pragma unroll
    for (int blk = 0; blk < DV / 32; ++blk)
#pragma unroll
        for (int r = 0; r < 16; ++r) o[blk][r] = 0.f;
    float mhat = 0.f, lrun = 0.f;
    f32x16 negm;
#pragma unroll
    for (int r = 0; r < 16; ++r) negm[r] = 0.f;
    const int NT = 4 * qb + 4, NTw = NT - 3 + (w >> 1);
    constexpr int DUMMY_OFF = 2 * KBYTES + 2 * VBYTES;
    const int dummy = DUMMY_OFF + tid * 16;
    int kl[KN], vl[VN]; unsigned kg[KN];
#pragma unroll
    for (int i = 0; i < KN; ++i) { const int c = tid + 512 * i; const bool ok = c < KCH; const int cc = ok ? c : KCH - 1; kl[i] = ok ? (cc / KC) * KP + (cc % KC) * 16 : -1; kg[i] = (unsigned)cc * 8u; }
#pragma unroll
    for (int i = 0; i < VN; ++i) { const int c = tid + 512 * i, d = c >> 3, cc = c & 7; vl[i] = VOFF + d * VP + cc * 16; }
    u32x4 kra[KN], vra[VN], krb[KN], vrb[VN];
#define ATT_GLOAD_K(t, kr) do { const int tt_ = (t) < NT ? (t) : NT - 1; _Pragma("unroll") for (int i_ = 0; i_ < KN; ++i_) kr[i_] = *(const u32x4*)(Kh + (size_t)tt_ * 64 * DK + kg[i_]); } while (0)
#define ATT_GLOAD_V(t, vr) do { const int tt_ = (t) < NT ? (t) : NT - 1; _Pragma("unroll") for (int i_ = 0; i_ < VN; ++i_) vr[i_] = *(const u32x4*)(Vth + (size_t)tt_ * (DV * 64) + (size_t)(tid + 512 * i_) * 8); } while (0)
#define ATT_LSTORE_K(slot, kr, valid) do { _Pragma("unroll") for (int i_ = 0; i_ < KN; ++i_) { const int a_ = ((valid) && kl[i_] >= 0) ? (slot) * KBYTES + kl[i_] : dummy; *(LAS u32x4*)(lds + a_) = kr[i_]; } } while (0)
#define ATT_LSTORE_V(slot, vr, valid) do { _Pragma("unroll") for (int i_ = 0; i_ < VN; ++i_) { const int a_ = (valid) ? (slot) * VBYTES + vl[i_] : dummy; *(LAS u32x4*)(lds + a_) = vr[i_]; } } while (0)
    ATT_GLOAD_K(0, kra); ATT_GLOAD_V(0, vra); ATT_GLOAD_K(1, krb); ATT_LSTORE_K(0, kra, true); ATT_LSTORE_V(0, vra, true); ATT_LSTORE_K(1, krb, true);
    ATT_GLOAD_K(2, krb); ATT_GLOAD_V(1, vrb);
    __syncthreads();
    f32x16 sa0, sa1, sb0, sb1;
    attn_qk<DK>(sa0, sa1, lds, qf, q, hi);
    asm volatile("s_waitcnt lgkmcnt(0)\n\ts_barrier" ::: "memory");
#define ATT_STAGE_LD(t, krl, vrl) do { ATT_GLOAD_K((t) + 3, krl); ATT_GLOAD_V((t) + 2, vrl); } while (0)
#define ATT_STAGE_ST(t, par, krs, vrs) do { ATT_LSTORE_K(par, krs, (t) + 2 < NT); ATT_LSTORE_V((par) ^ 1, vrs, (t) + 1 < NT); } while (0)
#define ATT_BAR() asm volatile("s_waitcnt lgkmcnt(0)\n\ts_barrier" ::: "memory")
#define ATT_STEP(t, c0, c1, n0, n1, par, krl, vrl, krs, vrs) do { \
        ATT_STAGE_LD(t, krl, vrl); \
        attn_prep<DV>(c0, c1, o, mhat, lrun, negm, (t) == 0, (t) - (NT - 4), w, q, hi); \
        attn_fused<DK, DV>(n0, n1, c0, c1, o, mhat, lrun, lds + ((par) ^ 1) * KBYTES, lds + VOFF + (par) * VBYTES, qf, negm, q, hi); \
        ATT_STAGE_ST(t, par, krs, vrs); \
        ATT_BAR(); } while (0)
    const int NTw2 = (NTw + 1) & ~1;
    int t = 0;
    for (; t < NTw2; t += 2) {
        ATT_STEP(t, sa0, sa1, sb0, sb1, 0, kra, vra, krb, vrb);
        ATT_STEP(t + 1, sb0, sb1, sa0, sa1, 1, krb, vrb, kra, vra);
    }
    for (; t < NT; t += 2) {
        ATT_STAGE_LD(t, kra, vra); ATT_STAGE_ST(t, 0, krb, vrb); ATT_BAR();
        ATT_STAGE_LD(t + 1, krb, vrb); ATT_STAGE_ST(t + 1, 1, kra, vra); ATT_BAR();
    }
#undef ATT_STAGE_LD
#undef ATT_STAGE_ST
#undef ATT_STEP
#undef ATT_GLOAD_K
#undef ATT_GLOAD_V
#undef ATT_LSTORE_K
#undef ATT_LSTORE_V
    { auto rr = __builtin_amdgcn_permlane32_swap(__float_as_uint(lrun), __float_as_uint(lrun), false, false); lrun = __uint_as_float(rr[0]) + __uint_as_float(rr[1]); }
    const float inv = 1.f / lrun;
#pragma unroll
    for (int blk = 0; blk < DV / 32; ++blk)
#pragma unroll
        for (int r = 0; r < 16; ++r) o[blk][r] *= inv;
}


__device__ __forceinline__ f32x2 cmadd(f32x2 a, f32x2 x, f32x2 b) { f32x2 r; r.x = a.x * x.x - a.y * x.y + b.x; r.y = a.x * x.y + a.y * x.x + b.y; return r; }
template <bool PASSC>
__device__ __forceinline__ void s5_pass(LAS unsigned char* lds, const float* __restrict__ U, const f32x2* __restrict__ AB, const f32x2* __restrict__ ABL, const f32x2* __restrict__ BB, f32x2* ST,
                                        const float* __restrict__ c_re, const float* __restrict__ c_im, const float* __restrict__ dsk, bf16_t* Gout, int gw, int NGW, int w, int lane) {
    LAS float* ut = (LAS float*)(lds + w * 8448);
    LAS bf16_t* xt = (LAS bf16_t*)(lds + w * 8448 + 4096);
    for (int it = gw; it < 8192; it += NGW) {
        const int bg = it >> 7, c = ((it & 127) + 32 * (it >> 11)) & 127, b = bg >> 5, g = bg & 31;
        const int e = g * 64 + lane;
        const f32x2 ab = AB[e];
        f32x2 bb[16];
        { const f32x4* bp = (const f32x4*)(BB + (size_t)e * 16);
#pragma unroll
          for (int i = 0; i < 8; ++i) { const f32x4 v = bp[i]; bb[2 * i] = (f32x2){v[0], v[1]}; bb[2 * i + 1] = (f32x2){v[2], v[3]}; } }
        const float* up = U + (size_t)(b * S_ + c * 64) * 512 + g * 16;
#pragma unroll
        for (int j = 0; j < 4; ++j) { const int row = (lane >> 2) + 16 * j; const f32x4 v = *(const f32x4*)(up + (size_t)row * 512 + (lane & 3) * 4); *(LAS f32x4*)(ut + row * 16 + (lane & 3) * 4) = v; }
        f32x2 x = {0.f, 0.f};
        bf16x8 cfr[4]; f32x4 dsk4 = {0.f, 0.f, 0.f, 0.f};
        if (PASSC) {
            const f32x2 al = ABL[e]; const f32x2* sp = ST + (size_t)bg * 128 * 64 + lane;
            int j = 0;
            for (; j + 8 <= c; j += 8) { f32x2 sv[8];
#pragma unroll
                for (int i = 0; i < 8; ++i) sv[i] = sp[(size_t)(j + i) * 64];
#pragma unroll
                for (int i = 0; i < 8; ++i) x = cmadd(al, x, sv[i]); }
            for (; j < c; ++j) { const f32x2 s = sp[(size_t)j * 64]; x = cmadd(al, x, s); }
            const int h = lane & 15, kq = lane >> 4;
#pragma unroll
            for (int ks = 0; ks < 4; ++ks) { const float* cp = ((ks < 2) ? c_re : c_im) + (size_t)(g * 16 + h) * 64 + 32 * (ks & 1) + 8 * kq; const float sg = (ks < 2) ? 1.f : -1.f;
                const f32x4 v0 = *(const f32x4*)cp * sg, v1 = *(const f32x4*)(cp + 4) * sg;
                u32x4 wv = {pk2(v0[0], v0[1]), pk2(v0[2], v0[3]), pk2(v1[0], v1[1]), pk2(v1[2], v1[3])}; cfr[ks] = __builtin_bit_cast(bf16x8, wv); }
            dsk4 = *(const f32x4*)(dsk + g * 16 + 4 * kq);
        }
        wave_lds_sync();
        for (int sub = 0; sub < 4; ++sub) {
            for (int t4 = 0; t4 < 16; t4 += 4) {
                f32x4 uv[4][4];
#pragma unroll
                for (int a_ = 0; a_ < 4; ++a_) { const LAS f32x4* ur = (const LAS f32x4*)(ut + (sub * 16 + t4 + a_) * 16);
#pragma unroll
                    for (int k = 0; k < 4; ++k) uv[a_][k] = ur[k]; }
#pragma unroll
                for (int a_ = 0; a_ < 4; ++a_) { f32x2 bq[4];
#pragma unroll
                    for (int k = 0; k < 4; ++k) { bq[k] = bb[4 * k] * uv[a_][k][0];
#pragma unroll
                        for (int i = 1; i < 4; ++i) bq[k] = bq[k] + bb[4 * k + i] * uv[a_][k][i]; }
                    const f32x2 bu = (bq[0] + bq[1]) + (bq[2] + bq[3]);
                    x = cmadd(ab, x, bu);
                    if (PASSC) { const int tt = t4 + a_; const unsigned wv = pk2(x.x, x.y); xt[tt * 136 + lane] = (bf16_t)(wv & 0xffffu); xt[tt * 136 + 64 + lane] = (bf16_t)(wv >> 16); } } }
            if (PASSC) {
                wave_lds_sync();
                f32x4 acc = {0.f, 0.f, 0.f, 0.f};
#pragma unroll
                for (int ks = 0; ks < 4; ++ks) { const bf16x8 bx = *(const LAS bf16x8*)(xt + (lane & 15) * 136 + 32 * ks + 8 * (lane >> 4));
                    acc = __builtin_amdgcn_mfma_f32_16x16x32_bf16(cfr[ks], bx, acc, 0, 0, 0); }
                const int tl = sub * 16 + (lane & 15), kq = lane >> 4;
                const f32x4 uu = *(const LAS f32x4*)(ut + tl * 16 + 4 * kq);
                float gv[4];
#pragma unroll
                for (int i = 0; i < 4; ++i) { const float y = acc[i] + dsk4[i] * uu[i]; const float z = 0.7978845608028654f * (y + 0.044715f * y * y * y);
                    gv[i] = y * __builtin_amdgcn_rcpf(1.f + __builtin_amdgcn_exp2f(-2.f * LOG2E * z)); }
                u32x2 wv = {pk2(gv[0], gv[1]), pk2(gv[2], gv[3])};
                *(u32x2*)(Gout + (size_t)(b * S_ + c * 64 + tl) * 512 + g * 16 + 4 * kq) = wv;
                wave_lds_sync();
            }
        }
        if (!PASSC) ST[((size_t)bg * 128 + c) * 64 + lane] = x;
        wave_lds_sync();
    }
}
constexpr size_t WS_BAR = 640 * 1024, BAR_ZERO_BYTES = 16 * 1024;
#define XB_TMO      128
#define XB_XCNT(j)  (256  + 64 * (j))
#define XB_XSUB(j)  (1280 + 64 * (j))
#define XB_XGEN(j)  (2304 + 64 * (j))
#define XB_TOP      3328
#define XB_TOPGEN   3392
#define XCD_BAR_WORDS 3456
#define XB_SPIN_CAP (1u << 18)

__device__ __forceinline__ unsigned xb_ld(unsigned* p)              { return __hip_atomic_load(p, __ATOMIC_RELAXED, __HIP_MEMORY_SCOPE_AGENT); }
__device__ __forceinline__ unsigned xb_add(unsigned* p, unsigned v) { return __hip_atomic_fetch_add(p, v, __ATOMIC_RELAXED, __HIP_MEMORY_SCOPE_AGENT); }
__device__ __forceinline__ unsigned xb_xcc_id() { return (unsigned)__builtin_amdgcn_s_getreg((3 << 11) | 20) & 0xFu; }
#define XB_SPIN(cond, bar) do { unsigned _sp = 0; while (cond) { __builtin_amdgcn_s_sleep(1); \
    if ((++_sp & 255u) == 0u) { if (xb_ld(&(bar)[XB_TMO])) break; if (_sp > XB_SPIN_CAP) { atomicAdd(&(bar)[XB_TMO], 1u); break; } } } } while (0)

struct XcdBarrier {
    unsigned* bar; unsigned x;
    volatile LAS unsigned* st;
};

__device__ __forceinline__ XcdBarrier xcd_barrier_post(unsigned* bar, volatile LAS unsigned* st) {
    XcdBarrier b; b.bar = bar; b.x = xb_xcc_id(); b.st = st;
    if (threadIdx.x == 0) (void)xb_add(&bar[XB_XCNT(b.x)], 1u);
    return b;
}
__device__ __forceinline__ void xcd_barrier_complete(unsigned* bar, unsigned x, unsigned& nloc, unsigned& nx) {
    const unsigned G = gridDim.x * gridDim.y * gridDim.z;
    unsigned sum, cnt, mine, sp = 0u;
    for (;;) {
        sum = 0u; cnt = 0u; mine = 0u;
#pragma unroll
        for (unsigned j = 0; j < 16; ++j) { const unsigned c = xb_ld(&bar[XB_XCNT(j)]); sum += c; cnt += (c > 0u) ? 1u : 0u; mine = (j == x) ? c : mine; }
        if (sum == G) break;
        __builtin_amdgcn_s_sleep(1);
        if ((++sp & 255u) == 0u) { if (xb_ld(&bar[XB_TMO])) break; if (sp > XB_SPIN_CAP) { atomicAdd(&bar[XB_TMO], 1u); break; } }
    }
    nloc = mine > 0u ? mine : 1u; nx = cnt > 0u ? cnt : 1u;
}

__device__ __forceinline__ void xcd_barrier(const XcdBarrier& b) {
    asm volatile("s_waitcnt vmcnt(0)" ::: "memory");
    __syncthreads();
    if (threadIdx.x == 0) {
        unsigned* bar = b.bar;
        __builtin_amdgcn_s_waitcnt(0);
        unsigned nloc = b.st[0], nx = b.st[1];
        if (nloc == 0u) { xcd_barrier_complete(bar, b.x, nloc, nx); b.st[0] = nloc; b.st[1] = nx; }
        const unsigned old = xb_add(&bar[XB_XSUB(b.x)], 1u);
        const unsigned gen = old / nloc;
        if (old + 1u == (gen + 1u) * nloc) {
            __builtin_amdgcn_fence(__ATOMIC_RELEASE, "agent");
            asm volatile("s_waitcnt vmcnt(0)" ::: "memory");
            const unsigned og = xb_add(&bar[XB_TOP], 1u);
            const unsigned tg = og / nx;
            if (og + 1u == (tg + 1u) * nx) xb_add(&bar[XB_TOPGEN], 1u);
            else XB_SPIN(xb_ld(&bar[XB_TOPGEN]) == tg, bar);
            __builtin_amdgcn_fence(__ATOMIC_ACQUIRE, "agent");
            xb_add(&bar[XB_XGEN(b.x)], 1u);
            asm volatile("s_waitcnt vmcnt(0)" ::: "memory");
        } else {
            XB_SPIN(xb_ld(&bar[XB_XGEN(b.x)]) == gen, bar);
            __builtin_amdgcn_fence(__ATOMIC_ACQUIRE, "agent");
            asm volatile("s_waitcnt vmcnt(0)" ::: "memory");
        }
    }
    __syncthreads();
}

constexpr int N_PHASES = 18;
#ifndef PHMASK
#define PHMASK 0x1fffff
#endif
#define EN(p) (((PHMASK) >> (p)) & 1)
#ifndef REP_FFNA
#define REP_FFNA 1
#endif
#ifndef REP_P0
#define REP_P0 1
#endif
#ifndef REP_S5A
#define REP_S5A 1
#endif
#ifndef REP_SYNC
#define REP_SYNC 1
#endif
#ifndef REP_MLA
#define REP_MLA 1
#endif
#ifndef REP_DIFF
#define REP_DIFF 1
#endif
#ifndef REP_S5C
#define REP_S5C 1
#endif
__global__ void __launch_bounds__(512) mega_fwd(Args a) {
    extern __shared__ __attribute__((aligned(16))) unsigned char lds_raw[];
    LAS unsigned char* lds = (LAS unsigned char*)lds_raw;
    const int G = gridDim.x, bx = blockIdx.x, vcu = (G % 8 == 0) ? (bx % 8) * (G / 8) + bx / 8 : bx;
    LAS unsigned long long* ptab = (LAS unsigned long long*)(lds + 131072);
    if (threadIdx.x == 0) {
        ptab[0] = (unsigned long long)a.in[0];
        ptab[1] = (unsigned long long)a.in[1];
        ptab[2] = (unsigned long long)a.in[2];
        ptab[3] = (unsigned long long)a.in[3];
        ptab[4] = (unsigned long long)a.in[4];
        ptab[5] = (unsigned long long)a.in[5];
        ptab[6] = (unsigned long long)a.in[6];
        ptab[7] = (unsigned long long)a.in[7];
        ptab[8] = (unsigned long long)a.in[8];
        ptab[9] = (unsigned long long)a.in[9];
        ptab[10] = (unsigned long long)a.in[10];
        ptab[11] = (unsigned long long)a.in[11];
        ptab[12] = (unsigned long long)a.in[12];
        ptab[13] = (unsigned long long)a.in[13];
        ptab[14] = (unsigned long long)a.in[14];
        ptab[15] = (unsigned long long)a.in[15];
        ptab[16] = (unsigned long long)a.in[16];
        ptab[17] = (unsigned long long)a.in[17];
        ptab[18] = (unsigned long long)a.in[18];
        ptab[19] = (unsigned long long)a.in[19];
        ptab[20] = (unsigned long long)a.in[20];
        ptab[21] = (unsigned long long)a.in[21];
        ptab[22] = (unsigned long long)a.in[22];
        ptab[23] = (unsigned long long)a.in[23];
        ptab[24] = (unsigned long long)a.in[24];
        ptab[25] = (unsigned long long)a.in[25];
        ptab[26] = (unsigned long long)a.in[26];
        ptab[27] = (unsigned long long)a.in[27];
        ptab[28] = (unsigned long long)a.in[28];
        ptab[29] = (unsigned long long)a.in[29];
        ptab[30] = (unsigned long long)a.in[30];
        ptab[31] = (unsigned long long)a.out; ptab[32] = (unsigned long long)a.ws;
        ((LAS unsigned*)(lds + 131072 + 768))[0] = 0u; ((LAS unsigned*)(lds + 131072 + 768))[1] = 0u; }
    __syncthreads();
    const XcdBarrier xbar = xcd_barrier_post((unsigned*)(a.ws + WS_BAR), (volatile LAS unsigned*)(lds + 131072 + 768));
#define LDP_(i) ldptr(ptab, (i))
#define x_in ((const float*)LDP_(0))
#define positions ((const int*)LDP_(1))
#define ffn_norm ((const float*)LDP_(2))
#define ffn_w_gu ((const float*)LDP_(3))
#define ffn_w_down ((const float*)LDP_(4))
#define ev_norm ((const float*)LDP_(5))
#define ev_w_in ((const float*)LDP_(6))
#define s5_lre ((const float*)LDP_(7))
#define s5_lim ((const float*)LDP_(8))
#define s5_logdt ((const float*)LDP_(9))
#define s5_bre ((const float*)LDP_(10))
#define s5_bim ((const float*)LDP_(11))
#define s5_cre ((const float*)LDP_(12))
#define s5_cim ((const float*)LDP_(13))
#define s5_d ((const float*)LDP_(14))
#define s5_wglu ((const float*)LDP_(15))
#define s5_bglu ((const float*)LDP_(16))
#define q_norm ((const float*)LDP_(17))
#define w_uq ((const float*)LDP_(18))
#define kv_norm ((const float*)LDP_(19))
#define w_ukv ((const float*)LDP_(20))
#define ev_w_out ((const float*)LDP_(21))
#define od_norm ((const float*)LDP_(22))
#define od_w_in ((const float*)LDP_(23))
#define lq1 ((const float*)LDP_(24))
#define lk1 ((const float*)LDP_(25))
#define lq2 ((const float*)LDP_(26))
#define lk2 ((const float*)LDP_(27))
#define subln ((const float*)LDP_(28))
#define od_w_out ((const float*)LDP_(29))
#define final_norm ((const float*)LDP_(30))
#define OUT ((float*)LDP_(31))
#define SS ((float*)(ws + (WS_SSL)))
#define AB ((f32x2*)(ws + (WS_S5P)))
#define ABL ((f32x2*)(ws + (WS_S5P + 2048 * 8)))
#define BB ((f32x2*)(ws + (WS_S5P + 4096 * 8)))
#define COSM ((float*)(ws + (WS_ROPE)))
#define SINM ((float*)(ws + (WS_ROPE + T_ * 16 * 4)))
#define COST ((float*)(ws + (WS_ROPE + T_ * 32 * 4)))
#define SINT ((float*)(ws + (WS_ROPE + T_ * 40 * 4)))
#define WGU ((bf16_t*)(ws + (WS_WGU)))
#define WD ((bf16_t*)(ws + (WS_WD)))
#define WEVIN ((bf16_t*)(ws + (WS_WEVIN)))
#define WUQ ((bf16_t*)(ws + (WS_WUQ)))
#define WUKV ((bf16_t*)(ws + (WS_WUKV)))
#define WGLU ((bf16_t*)(ws + (WS_WGLU)))
#define WEVOUT ((bf16_t*)(ws + (WS_WEVOUT)))
#define WODIN ((bf16_t*)(ws + (WS_WODIN)))
#define WODOUT ((bf16_t*)(ws + (WS_WODOUT)))
#define XB ((bf16_t*)(ws + (WS_XB)))
#define ACT ((bf16_t*)(ws + (WS_ACT)))
#define U ((float*)(ws + (WS_U)))
#define CQ ((bf16_t*)(ws + (WS_CQ)))
#define CKV ((bf16_t*)(ws + (WS_CKV)))
#define KPE ((bf16_t*)(ws + (WS_KPE)))
#define Q1 ((bf16_t*)(ws + (WS_Q1)))
#define K1 ((bf16_t*)(ws + (WS_K1)))
#define VT1 ((bf16_t*)(ws + (WS_VT1)))
#define ST ((f32x2*)(ws + (WS_ST)))
#define GB ((bf16_t*)(ws + (WS_G)))
#define MIX ((bf16_t*)(ws + (WS_MIX)))
#define Q2 ((bf16_t*)(ws + (WS_Q2)))
#define K2 ((bf16_t*)(ws + (WS_K2)))
#define VT2 ((bf16_t*)(ws + (WS_VT2)))
#define OA ((bf16_t*)(ws + (WS_OA)))
    for (int ph = a.ph_lo; ph < a.ph_hi; ++ph) {
#define TIDVARS const int tid = opaque_tid(), lane = tid & 63, w = __builtin_amdgcn_readfirstlane(tid >> 6), gw = vcu * 8 + w, gt = bx * 512 + tid; (void)lane; (void)gw; (void)gt
        unsigned char* const ws = (unsigned char*)LDP_(32);
        int Gv = G; asm volatile("" : "+s"(Gv)); const int NGW = Gv * 8, NGT = Gv * 512;
        const bool ffn_a = (ph == 1 || ph == 8 || ph == 10 || ph == 15), ffn_b = (ph == 2 || ph == 9 || ph == 11 || ph == 16);
        if (EN(0) && ph == 0) { for (int rep0_ = 0; rep0_ < REP_P0; ++rep0_) { TIDVARS;
            LAS float* scr = (LAS float*)(lds + w * 8448);
            constexpr int I_GU = 16 * 176, I_D = 44 * 32, I_EVIN = 16 * 40, I_UQ = 6 * 24, I_UKV = 4 * 32, I_GLU = 8 * 16, I_SQ = 16 * 32, I_ODIN = 16 * 96;
            constexpr int NITEMS = 4 * I_GU + 4 * I_D + I_EVIN + I_UQ + I_UKV + I_GLU + I_SQ + I_ODIN + I_SQ;
            for (int it = gw; it < NITEMS; it += NGW) {
                int r = it; const float* W; const float* gain = nullptr; bf16_t* WT; int K, Ns, Nd, mode = 0;
                if (r < 4 * I_GU) { const int i = r / I_GU; r -= i * I_GU; W = ffn_w_gu + (size_t)i * D_ * 2 * FF_; gain = ffn_norm + i * D_; WT = WGU + (size_t)i * 2 * FF_ * D_; K = D_; Ns = 2 * FF_; Nd = 2 * FF_; mode = 1; }
                else if ((r -= 4 * I_GU) < 4 * I_D) { const int i = r / I_D; r -= i * I_D; W = ffn_w_down + (size_t)i * FF_ * D_; WT = WD + (size_t)i * D_ * FF_; K = FF_; Ns = D_; Nd = D_; }
                else if ((r -= 4 * I_D) < I_EVIN) { W = ev_w_in; gain = ev_norm; WT = WEVIN; K = D_; Ns = 1184; Nd = 1280; mode = 2; }
                else if ((r -= I_EVIN) < I_UQ) { W = w_uq; gain = q_norm; WT = WUQ; K = 384; Ns = 768; Nd = 768; mode = 3; }
                else if ((r -= I_UQ) < I_UKV) { W = w_ukv; gain = kv_norm; WT = WUKV; K = 256; Ns = 1024; Nd = 1024; }
                else if ((r -= I_UKV) < I_GLU) { W = s5_wglu; WT = WGLU; K = 512; Ns = 512; Nd = 512; }
                else if ((r -= I_GLU) < I_SQ) { W = ev_w_out; WT = WEVOUT; K = D_; Ns = D_; Nd = D_; }
                else if ((r -= I_SQ) < I_ODIN) { W = od_w_in; gain = od_norm; WT = WODIN; K = D_; Ns = 3072; Nd = 3072; mode = 4; }
                else { r -= I_ODIN; W = od_w_out; WT = WODOUT; K = D_; Ns = D_; Nd = D_; }
                const int NB = Nd / 32, kb = r / NB, nb = r - kb * NB; int n0s, pm; map_block(mode, nb * 32, n0s, pm);
                tr_item(W, K, Ns, n0s, pm, gain, WT, nb * 32, kb * 64, scr, lane);
            }
            for (int m = gw; m < T_; m += NGW) { const f32x4* xr = (const f32x4*)(x_in + (size_t)m * D_) + lane; float s = 0.f;
#pragma unroll
                for (int j = 0; j < 4; ++j) { const f32x4 v = xr[64 * j]; s += (v[0] * v[0] + v[1] * v[1]) + (v[2] * v[2] + v[3] * v[3]);
                    u32x2 o = {pk2(v[0], v[1]), pk2(v[2], v[3])}; *(u32x2*)(XB + (size_t)m * D_ + (64 * j + lane) * 4) = o; }
                s = wave_sum(s); if (lane < 16) SS[(size_t)m * 16 + lane] = (lane == 0) ? s : 0.f; }
            for (int e = gt; e < T_ * 24; e += NGT) { const bool mm = e < T_ * 16; const int e2 = mm ? e : e - T_ * 16; const int t = mm ? (e2 >> 4) : (e2 >> 3), i = mm ? (e2 & 15) : (e2 & 7);
                const double ang = (double)positions[t] * (double)(mm ? INV_M[i] : INV_T[i]); const double kk = __builtin_rint(ang * 0.15915494309189535);
                const float r = (float)(ang - kk * 6.283185307179586);
                if (mm) { COSM[e2] = cosf(r); SINM[e2] = sinf(r); } else { COST[e2] = cosf(r); SINT[e2] = sinf(r); } }
            for (int e = gt; e < 2048; e += NGT) { const int g = e >> 6; const float dt = expf(s5_logdt[g]), lr = s5_lre[e], li = s5_lim[e];
                const float mag = expf(lr * dt), ang = li * dt, are = mag * cosf(ang), aim = mag * sinf(ang);
                const float den = lr * lr + li * li, nr = are - 1.f, fre = (nr * lr + aim * li) / den, fim = (aim * lr - nr * li) / den;
                AB[e] = (f32x2){are, aim};
                const float mag64 = expf(lr * dt * 64.f), ang64 = ang * 64.f; ABL[e] = (f32x2){mag64 * cosf(ang64), mag64 * sinf(ang64)};
                for (int h = 0; h < 16; ++h) { const float br = s5_bre[e * 16 + h], bi = s5_bim[e * 16 + h]; BB[e * 16 + h] = (f32x2){fre * br - fim * bi, fre * bi + fim * br}; } }
        } } else if (EN(1) && ffn_a) {
            const int idx = (ph == 1) ? 0 : (ph == 8) ? 1 : (ph == 10) ? 2 : 3; const int si = (ph == 1) ? 0 : (ph == 8) ? 2 : (ph == 10) ? 3 : 5;
            pg8::Gemm g{XB, WGU + (size_t)idx * 2 * FF_ * D_, T_, 2 * FF_, D_, D_, D_}; pg8::StaticOrder S; S.init(T_, 2 * FF_, G, bx);
            EpiSwiglu E{ACT, SS + (size_t)si * T_ * 16};
            for (int rep_ = 0; rep_ < REP_FFNA; ++rep_) { pg8::gemm_phase<EpiSwiglu, pg8::StaticOrder, true, true>(lds, g, S, E); __syncthreads(); }
        } else if (EN(2) && ffn_b) {
            const int idx = (ph == 2) ? 0 : (ph == 9) ? 1 : (ph == 11) ? 2 : 3; const int so = (ph == 2) ? 1 : (ph == 9) ? 3 : (ph == 11) ? 4 : -1;
            pg8::Gemm g{ACT, WD + (size_t)idx * D_ * FF_, T_, D_, FF_, FF_, FF_}; pg8::StaticOrder S; S.init(T_, D_, G, bx);
            EpiResid E{ph == 2 ? x_in : nullptr, XB, so >= 0 ? nullptr : OUT, so >= 0 ? XB : nullptr, so >= 0 ? SS + (size_t)so * T_ * 16 : nullptr, 0.5f};
            pg8::gemm_phase<EpiResid, pg8::StaticOrder, true, true>(lds, g, S, E);
        } else if (EN(7) && (ph == 7 || ph == 14)) {
            pg8::Gemm g{ph == 7 ? MIX : OA, ph == 7 ? WEVOUT : WODOUT, T_, D_, D_, D_, D_}; pg8::StaticOrder S; S.init(T_, D_, G, bx);
            EpiResid E{nullptr, XB, nullptr, XB, SS + (size_t)(ph == 7 ? 2 : 5) * T_ * 16, 1.0f};
            pg8::gemm_phase<EpiResid, pg8::StaticOrder, true, true>(lds, g, S, E);
        } else if (EN(3) && ph == 3) {
            pg8::Gemm g{XB, WEVIN, T_, 1280, D_, D_, D_}; pg8::StaticOrder S; S.init(T_, 1280, G, bx);
            EpiEvIn E{SS + (size_t)1 * T_ * 16, U, CQ, CKV, KPE, SS + (size_t)6 * T_ * 16, SS + (size_t)7 * T_ * 16, COSM, SINM};
            pg8::gemm_phase<EpiEvIn, pg8::StaticOrder, true, true>(lds, g, S, E);
        } else if (EN(4) && ph == 4) {
            if (EN(18)) { pg8::Gemm g{CQ, WUQ, T_, 768, 384, 384, 384}; pg8::StaticOrder S; S.init(T_, 768, G, bx);
              EpiQ E{SS + (size_t)6 * T_ * 16, Q1, COSM, SINM};
              pg8::gemm_phase<EpiQ, pg8::StaticOrder, true, true>(lds, g, S, E); }
            __syncthreads();
            if (EN(19)) { pg8::Gemm g{CKV, WUKV, T_, 1024, 256, 256, 256}; pg8::StaticOrder S; S.init(T_, 1024, G, bx);
              EpiKV E{SS + (size_t)7 * T_ * 16, K1, VT1, KPE};
              pg8::gemm_phase<EpiKV, pg8::StaticOrder, true, true>(lds, g, S, E); }
            __syncthreads();
            if (EN(20)) for (int rep_ = 0; rep_ < REP_S5A; ++rep_) { TIDVARS; s5_pass<false>(lds, U, AB, ABL, BB, ST, s5_cre, s5_cim, s5_d, GB, gw, NGW, w, lane); }
        } else if (EN(5) && ph == 5) {
            for (int rep_ = 0; rep_ < REP_MLA; ++rep_) for (int i = vcu; i < 256; i += G) { const int bh = i >> 4, s = i & 15;
#pragma unroll 1
                for (int k = 0; k < 2; ++k) { const int qb = k ? s : 31 - s; f32x16 o[2];
                    attn_unit<96, 64>(Q1 + (size_t)bh * S_ * 96, K1 + (size_t)bh * S_ * 96, VT1 + (size_t)bh * 64 * S_, qb, lds, o);
                    TIDVARS; const int q = lane & 31, hi = lane >> 5; const int row = (bh >> 3) * S_ + qb * 256 + w * 32 + q;
                    bf16_t* op = MIX + (size_t)row * D_ + 512 + (bh & 7) * 64;
#pragma unroll
                    for (int blk = 0; blk < 2; ++blk)
#pragma unroll
                        for (int r4 = 0; r4 < 4; ++r4) { u32x2 v = {pk2(o[blk][4 * r4], o[blk][4 * r4 + 1]), pk2(o[blk][4 * r4 + 2], o[blk][4 * r4 + 3])}; *(u32x2*)(op + 32 * blk + 8 * r4 + 4 * hi) = v; } } }
            __syncthreads();
            for (int rep_ = 0; rep_ < REP_S5C; ++rep_) { TIDVARS; s5_pass<true>(lds, U, AB, ABL, BB, ST, s5_cre, s5_cim, s5_d, GB, gw, NGW, w, lane); }
        } else if (EN(6) && ph == 6) {
            pg8::Gemm g{GB, WGLU, T_, 512, 512, 512, 512}; pg8::StaticOrder S; S.init(T_, 512, G, bx);
            EpiGlu E{GB, s5_bglu, MIX};
            pg8::gemm_phase<EpiGlu, pg8::StaticOrder, true, true>(lds, g, S, E);
        } else if (EN(12) && ph == 12) {
            pg8::Gemm g{XB, WODIN, T_, 3072, D_, D_, D_}; pg8::StaticOrder S; S.init(T_, 3072, G, bx);
            EpiOdIn E{SS + (size_t)4 * T_ * 16, Q2, K2, VT2, COST, SINT};
            pg8::gemm_phase<EpiOdIn, pg8::StaticOrder, true, true>(lds, g, S, E);
        } else if (EN(13) && ph == 13) {
            float lam;
            { TIDVARS; const float pa = lq1[lane] * lk1[lane], pb = lq2[lane] * lk2[lane]; lam = expf(wave_sum(pa)) - expf(wave_sum(pb)) + LAM_INIT; }
            for (int rep_ = 0; rep_ < REP_DIFF; ++rep_) for (int i = vcu; i < 256; i += G) { const int bh = i >> 4, s = i & 15;
#pragma unroll 1
                for (int k = 0; k < 2; ++k) { const int qb = k ? s : 31 - s; f32x16 o[4];
#define O1S_PTR(tidv) ((f32x4*)(ws + WS_O1S) + (size_t)(bx * 8 + ((tidv) >> 6)) * 16 * 64 + ((tidv) & 63))
#pragma unroll 1
                    for (int mi = 0; mi < 2; ++mi) {
                        attn_unit<64, 128>(Q2 + (size_t)(bh * 2 + mi) * S_ * 64, K2 + (size_t)(bh * 2 + mi) * S_ * 64, VT2 + (size_t)bh * 128 * S_, qb, lds, o);
                        if (mi == 0) { f32x4* o1s = O1S_PTR(opaque_tid());
#pragma unroll
                            for (int blk = 0; blk < 4; ++blk)
#pragma unroll
                                for (int r4 = 0; r4 < 4; ++r4) o1s[(blk * 4 + r4) * 64] = (f32x4){o[blk][4 * r4], o[blk][4 * r4 + 1], o[blk][4 * r4 + 2], o[blk][4 * r4 + 3]}; } }
                    TIDVARS; const f32x4* o1s = O1S_PTR(tid);
                    float sq = 0.f;
#pragma unroll
                    for (int blk = 0; blk < 4; ++blk)
#pragma unroll
                        for (int r4 = 0; r4 < 4; ++r4) { const f32x4 o1v = o1s[(blk * 4 + r4) * 64];
#pragma unroll
                            for (int i = 0; i < 4; ++i) { const float v = o1v[i] - lam * o[blk][4 * r4 + i]; o[blk][4 * r4 + i] = v; sq += v * v; } }
                    sq += __shfl_xor(sq, 32);
                    const float rs = __builtin_amdgcn_rsqf(sq * (1.f / 128.f) + EPS) * (1.f - LAM_INIT);
                    const int q = lane & 31, hi = lane >> 5; const int row = (bh >> 3) * S_ + qb * 256 + w * 32 + q;
                    bf16_t* op = OA + (size_t)row * D_ + (bh & 7) * 128;
#pragma unroll
                    for (int blk = 0; blk < 4; ++blk)
#pragma unroll
                        for (int r4 = 0; r4 < 4; ++r4) { const int d = 32 * blk + 8 * r4 + 4 * hi; const f32x4 gn = *(const f32x4*)(subln + d);
                            u32x2 v = {pk2(o[blk][4 * r4] * rs * gn[0], o[blk][4 * r4 + 1] * rs * gn[1]), pk2(o[blk][4 * r4 + 2] * rs * gn[2], o[blk][4 * r4 + 3] * rs * gn[3])};
                            *(u32x2*)(op + d) = v; } } }
        } else if (EN(17) && ph == 17) { TIDVARS;
            for (int m = gw; m < T_; m += NGW) { f32x4* xr = (f32x4*)(OUT + (size_t)m * D_) + lane; f32x4 v[4]; float s = 0.f;
#pragma unroll
                for (int j = 0; j < 4; ++j) { v[j] = xr[64 * j]; s += (v[j][0] * v[j][0] + v[j][1] * v[j][1]) + (v[j][2] * v[j][2] + v[j][3] * v[j][3]); }
                const float rs = __builtin_amdgcn_rsqf(wave_sum(s) * (1.f / D_) + EPS);
#pragma unroll
                for (int j = 0; j < 4; ++j) { const f32x4 gn = *((const f32x4*)final_norm + 64 * j + lane); xr[64 * j] = v[j] * rs * gn; } }
        }
        if (ph + 1 < a.ph_hi) for (int rs_ = 0; rs_ < REP_SYNC; ++rs_) { if (a.ph_hi > N_PHASES) cg::this_grid().sync(); else xcd_barrier(xbar); }
    }
}

extern "C" void kernel_launch(void* const* d_in, const int* in_sizes, int n_in, void* d_out, int out_size, void* d_ws, size_t ws_size, hipStream_t stream) {
    static int grid = 0;
    if (grid == 0) {
        if (n_in != 31 || out_size != T_ * D_ || ws_size < WS_END) { fprintf(stderr, "kernel_launch: unexpected problem (n_in %d, out %d, ws %zu)\n", n_in, out_size, ws_size); grid = -1; return; }
        int dev = 0, cus = 0, per_cu = 0;
        hipGetDevice(&dev); hipDeviceGetAttribute(&cus, hipDeviceAttributeMultiprocessorCount, dev);
        hipFuncSetAttribute((const void*)mega_fwd, hipFuncAttributeMaxDynamicSharedMemorySize, LDS_BYTES);
        hipOccupancyMaxActiveBlocksPerMultiprocessor(&per_cu, (const void*)mega_fwd, 512, LDS_BYTES);
        if (per_cu < 1) { fprintf(stderr, "kernel_launch: occupancy query says %d blocks per CU\n", per_cu); per_cu = 1; }
        if (per_cu > 1) per_cu = 1;
        grid = cus * per_cu;
        (void)hipGetLastError();
    }
    if (grid < 0) return;
    if (hipMemsetAsync((char*)d_ws + WS_BAR, 0, BAR_ZERO_BYTES, stream) != hipSuccess) { fprintf(stderr, "kernel_launch: hipMemsetAsync of the barrier words failed\n"); return; }
    Args a{};
    for (int i = 0; i < 31; ++i) a.in[i] = d_in[i];
    a.out = (float*)d_out; a.ws = (unsigned char*)d_ws; a.ph_lo = 0; a.ph_hi = N_PHASES;
    void* kargs[] = {&a};
    hipError_t e = hipLaunchCooperativeKernel((const void*)mega_fwd, dim3(grid), dim3(512), kargs, LDS_BYTES, stream);
    if (e != hipSuccess) fprintf(stderr, "kernel_launch: cooperative launch failed: %s (grid %d)\n", hipGetErrorString(e), grid);
}
```
